# Optimizing an MI355X kernel written in HIP

```python
import jax, jax.numpy as jnp
from jax import lax
import numpy as np

D_MODEL = 1024
BATCH = 2
SEQ = 8192
DEPTH = 1

CHUNK = 64
D_MIX = D_MODEL
D_GMLP = D_MIX // 2
D_HGRN = D_MIX - D_GMLP
GMLP_HEADS = 4
GMLP_HEAD_DIM = D_GMLP // GMLP_HEADS
GMLP_BLOCK = 128
HGRN_HEADS = 4
HGRN_HEAD_DIM = D_HGRN // HGRN_HEADS
D_FF = -(-(8 * D_MODEL) // (3 * 256)) * 256
N_ADA = 6
D_IN = 2 * D_GMLP + 4 * D_HGRN
EPS = 1e-6

kernel_name = "hybrid_gmlp_hgrn2_adaln_block"


def rmsnorm(x, w):
    xf = x.astype(jnp.float32)
    y = xf * lax.rsqrt(jnp.mean(xf * xf, axis=-1, keepdims=True) + EPS)
    return (y * w.astype(jnp.float32)).astype(x.dtype)


def layernorm(x, w, b):
    xf = x.astype(jnp.float32)
    mu = jnp.mean(xf, axis=-1, keepdims=True)
    var = jnp.mean(jnp.square(xf - mu), axis=-1, keepdims=True)
    y = (xf - mu) * lax.rsqrt(var + EPS)
    return (y * w.astype(jnp.float32) + b.astype(jnp.float32)).astype(x.dtype)


def modulate(h, shift, scale):
    return h * (1 + scale[:, None, :]) + shift[:, None, :]


def gmlp_spatial_gating(u, v, w_s, b_s, ln_w, ln_b):
    bsz, seq, _ = u.shape
    nb = seq // GMLP_BLOCK
    u = jax.nn.gelu(u, approximate=False)
    v = layernorm(jax.nn.gelu(v, approximate=False), ln_w, ln_b)
    vb = v.reshape(bsz, nb, GMLP_BLOCK, GMLP_HEADS, GMLP_HEAD_DIM)
    cid = jnp.arange(GMLP_BLOCK) // CHUNK
    mask = cid[:, None] >= cid[None, :]
    ws = jnp.where(mask[None], w_s, 0).astype(v.dtype)
    mixed = jnp.einsum('hts,bnshc->bnthc', ws, vb) + b_s.T.astype(v.dtype)[None, None, :, :, None]
    return u * mixed.reshape(bsz, seq, D_GMLP)


def hgrn2_recurrence(q, f_logit, inp, g, lb, gn_w):
    dtype = q.dtype
    bsz, seq, _ = q.shape
    nc = seq // CHUNK
    qf = jax.nn.silu(q.astype(jnp.float32))
    f = lb + (1.0 - lb) * jax.nn.sigmoid(f_logit.astype(jnp.float32))
    logf = jnp.log(f)
    k = 1.0 - f
    vf = inp.astype(jnp.float32)

    def to_chunks(t):
        return t.reshape(bsz, nc, CHUNK, HGRN_HEADS, HGRN_HEAD_DIM).transpose(1, 0, 3, 2, 4)

    tri = jnp.arange(CHUNK)[:, None] >= jnp.arange(CHUNK)[None, :]

    def step(state, xs):
        qc, kc, vc, lc = xs
        b = jnp.cumsum(lc, axis=2)
        inter = jnp.einsum('bhtd,bhde->bhte', qc * jnp.exp(b), state)
        diff = b[:, :, :, None, :] - b[:, :, None, :, :]
        decay = jnp.where(tri[:, :, None], jnp.exp(jnp.minimum(diff, 0.0)), 0.0)
        attn = jnp.einsum('bhtd,bhsd,bhtsd->bhts', qc, kc, decay)
        intra = jnp.einsum('bhts,bhse->bhte', attn, vc)
        b_last = b[:, :, -1, :]
        state = state * jnp.exp(b_last)[..., None] + jnp.einsum(
            'bhsd,bhse->bhde', kc * jnp.exp(b_last[:, :, None, :] - b), vc)
        return state, inter + intra

    s0 = jnp.zeros((bsz, HGRN_HEADS, HGRN_HEAD_DIM, HGRN_HEAD_DIM), jnp.float32)
    _, o = lax.scan(step, s0, (to_chunks(qf), to_chunks(k), to_chunks(vf), to_chunks(logf)))
    o = o.transpose(1, 0, 3, 2, 4).reshape(bsz, seq, HGRN_HEADS, HGRN_HEAD_DIM)
    gate = jax.nn.silu(g.astype(jnp.float32)).reshape(bsz, seq, HGRN_HEADS, HGRN_HEAD_DIM)
    o = rmsnorm(o, gn_w) * gate
    return o.reshape(bsz, seq, D_HGRN).astype(dtype)


def setup_inputs(seed: int = 0) -> dict:
    key = jax.random.key(seed)
    ks = jax.random.split(key, 20)
    nrm = lambda k, shape, s: jax.random.normal(k, shape, jnp.float32) * s
    return {
        "x": nrm(ks[0], (BATCH, SEQ, D_MODEL), 1.0),
        "c": nrm(ks[1], (BATCH, D_MODEL), 1.0),
        "w_ada": nrm(ks[2], (DEPTH, D_MODEL, N_ADA * D_MODEL), 0.5 * D_MODEL ** -0.5),
        "b_ada": nrm(ks[3], (DEPTH, N_ADA * D_MODEL), 0.02),
        "norm1_w": 1.0 + nrm(ks[4], (DEPTH, D_MODEL), 0.02),
        "w_in": nrm(ks[5], (DEPTH, D_MODEL, D_IN), D_MODEL ** -0.5),
        "w_s": nrm(ks[6], (DEPTH, GMLP_HEADS, GMLP_BLOCK, GMLP_BLOCK), GMLP_BLOCK ** -0.5),
        "b_s": 1.0 + nrm(ks[7], (DEPTH, GMLP_HEADS, GMLP_BLOCK), 0.02),
        "v_ln_w": 1.0 + nrm(ks[8], (DEPTH, D_GMLP), 0.02),
        "v_ln_b": nrm(ks[9], (DEPTH, D_GMLP), 0.02),
        "lower_bounds": nrm(ks[10], (DEPTH + 1, D_HGRN), 0.5),
        "gn_w": 1.0 + nrm(ks[11], (DEPTH, HGRN_HEAD_DIM), 0.02),
        "w_out": nrm(ks[12], (DEPTH, D_MIX, D_MODEL), D_MIX ** -0.5),
        "norm2_w": 1.0 + nrm(ks[13], (DEPTH, D_MODEL), 0.02),
        "w_ffn_in": nrm(ks[14], (DEPTH, D_MODEL, 2 * D_FF), D_MODEL ** -0.5),
        "w_ffn_out": nrm(ks[15], (DEPTH, D_FF, D_MODEL), D_FF ** -0.5),
        "final_norm_w": 1.0 + nrm(ks[16], (D_MODEL,), 0.02),
    }


def reference(x, c, w_ada, b_ada, norm1_w, w_in, w_s, b_s, v_ln_w, v_ln_b,
              lower_bounds, gn_w, w_out, norm2_w, w_ffn_in, w_ffn_out, final_norm_w):
    lb_all = jnp.cumsum(jax.nn.softmax(lower_bounds.astype(jnp.float32), axis=0), axis=0)
    c_act = jax.nn.silu(c)
    split_at = [D_GMLP, 2 * D_GMLP, 2 * D_GMLP + D_HGRN,
                2 * D_GMLP + 2 * D_HGRN, 2 * D_GMLP + 3 * D_HGRN]
    for l in range(DEPTH):
        ada = (c_act @ w_ada[l] + b_ada[l]).astype(x.dtype)
        sh1, sc1, g1, sh2, sc2, g2 = jnp.split(ada, N_ADA, axis=-1)

        h = modulate(rmsnorm(x, norm1_w[l]), sh1, sc1)
        proj = h @ w_in[l]
        u, v, q, f_logit, inp, g = jnp.split(proj, split_at, axis=-1)
        y_a = gmlp_spatial_gating(u, v, w_s[l], b_s[l], v_ln_w[l], v_ln_b[l])
        y_b = hgrn2_recurrence(q, f_logit, inp, g, lb_all[l], gn_w[l])
        mix = jnp.concatenate([y_a, y_b], axis=-1) @ w_out[l]
        x = x + g1[:, None, :] * mix

        h = modulate(rmsnorm(x, norm2_w[l]), sh2, sc2)
        gate, up = jnp.split(h @ w_ffn_in[l], 2, axis=-1)
        x = x + g2[:, None, :] * ((jax.nn.silu(gate) * up) @ w_ffn_out[l])
    return rmsnorm(x, final_norm_w)
```

```cpp
#include <hip/hip_runtime.h>
#include <hip/hip_cooperative_groups.h>
#include <cstdio>
#include <cstdint>
namespace pg8 {
#define PG8_LAS __attribute__((address_space(3)))
typedef unsigned short bf16_t;
typedef short bf16x8 __attribute__((ext_vector_type(8)));
typedef float f32x4 __attribute__((ext_vector_type(4)));
typedef unsigned u32x4 __attribute__((ext_vector_type(4)));
constexpr int BM = 256, BK = 64, HALF = 128, HTB = HALF * BK * 2  , STAGE_BYTES = 8 * HTB, NXCD = 8, WGM = 8;

__host__ __device__ __forceinline__ int lds_byte(int r, int c) { const int st = (r >> 4) * 2 + (c >> 5), rr = r & 15, cc = c & 31, ob = rr * 64 + cc * 2; return st * 1024 + (ob ^ (((ob >> 9) & 1) << 5)); }
__host__ __device__ __forceinline__ void stage_rc(int b, int& R, int& C) { const int st = b / 1024, sb = b % 1024, swz = sb ^ (((sb >> 9) & 1) << 5); R = (st >> 1) * 16 + swz / 64; C = (st & 1) * 32 + (swz % 64) / 2; }
__host__ __device__ __forceinline__ int perm32(int rho) { const int n = rho >> 4, i = rho & 15; return 8 * (i >> 2) + 4 * n + (i & 3); }

struct Unit { int pm, pn; };
struct Gemm { const bf16_t* A; const bf16_t* Bt; int M, N, K; };

struct StaticOrder {
    int nM, nN, nwg, G, c;
    __host__ __device__ void init(int M, int N, int G_, int c_) { nM = M / BM; nN = N / BM; nwg = nM * nN; G = G_; c = c_; }
    __host__ __device__ bool next(int i, Unit& u) const {
        const long L = (long)i * G + c; if (L >= nwg) return false;
        int wgid = (int)L; { const int q = nwg / NXCD, r = nwg % NXCD, xcd = wgid % NXCD, off = wgid / NXCD; wgid = (xcd < r ? xcd * (q + 1) : r * (q + 1) + (xcd - r) * q) + off; }
        const int nig = WGM * nN, gid = wgid / nig, fm = gid * WGM, gsz = (nM - fm) < WGM ? (nM - fm) : WGM;
        u.pm = fm + ((wgid % nig) % gsz); u.pn = (wgid % nig) / gsz; return true;
    }
    __device__ __forceinline__ void a_ready(const Unit&) const {}
    __device__ __forceinline__ void done(const Unit&) const {}
};

__device__ __forceinline__ unsigned cvt_pk_bf16(float lo, float hi) { unsigned r; asm volatile("v_cvt_pk_bf16_f32 %0, %1, %2" : "=v"(r) : "v"(lo), "v"(hi)); return r; }
typedef float f32x2 __attribute__((ext_vector_type(2)));
__device__ __forceinline__ f32x2 gelu_pk(f32x2 v) {
    const f32x2 av = __builtin_elementwise_abs(v), d = av * 0.2316418882f + 1.0f;
    f32x2 t; t.x = __builtin_amdgcn_rcpf(d.x); t.y = __builtin_amdgcn_rcpf(d.y);
    f32x2 q = t * 0.5307027145f + (-0.7265760135f); q = q * t + 0.7107068705f; q = q * t + (-0.142248368f); q = q * t + 0.127414796f; q = q * t;
    const f32x2 s = (v * v) * (-0.72134752044f);
    f32x2 e; e.x = __builtin_amdgcn_exp2f(s.x); e.y = __builtin_amdgcn_exp2f(s.y);
    const f32x2 m = v * (q * e), r = v - m;
    f32x2 o; o.x = v.x < 0.f ? m.x : r.x; o.y = v.y < 0.f ? m.y : r.y; return o;
}

template <int ACT  > struct EpiBf16 {
    static constexpr bool PERM = true, AFTER_DRAIN = false; static_assert(ACT == 0 || ACT == 1, "EpiBf16: ACT is 0 (none) or 1 (gelu_pk)");
    bf16_t* O; int ldc; const float* bias; int split_cols; size_t split_stride; float scale0;
    __device__ __forceinline__ void operator()(const f32x4 (&acc)[2][2][4][2], const Unit& u, int wr, int wc, int fr, int fq) const {
        const int row0 = u.pm * BM + wr * 64 + fr; int colt = u.pn * BM; bf16_t* base = O;
        float sc = 1.f; if (split_cols) { const int t = colt / split_cols; base += (size_t)t * split_stride; colt -= t * split_cols; if (t == 0) sc = scale0; }
        const int col0 = colt + wc * 32 + 8 * fq, bcol0 = u.pn * BM + wc * 32 + 8 * fq;
        f32x4 bv[2][2];
#pragma unroll
        for (int bj = 0; bj < 2; ++bj)
#pragma unroll
            for (int n = 0; n < 2; ++n) bv[bj][n] = bias ? *(const f32x4*)(bias + bcol0 + bj * HALF + 4 * n) : (f32x4){0.f, 0.f, 0.f, 0.f};
#pragma unroll
        for (int ai = 0; ai < 2; ++ai)
#pragma unroll
            for (int m = 0; m < 4; ++m) { bf16_t* rowp = base + (size_t)(row0 + ai * HALF + m * 16) * ldc + col0;
#pragma unroll
                for (int bj = 0; bj < 2; ++bj) { f32x4 v0 = acc[ai][bj][m][0] + bv[bj][0], v1 = acc[ai][bj][m][1] + bv[bj][1];
                    if (ACT == 1) { f32x2 a = gelu_pk((f32x2){v0[0], v0[1]}), b = gelu_pk((f32x2){v0[2], v0[3]}), c = gelu_pk((f32x2){v1[0], v1[1]}), d = gelu_pk((f32x2){v1[2], v1[3]});
                        v0 = (f32x4){a.x, a.y, b.x, b.y}; v1 = (f32x4){c.x, c.y, d.x, d.y}; }
                    v0 = v0 * sc; v1 = v1 * sc; u32x4 w; w.x = cvt_pk_bf16(v0[0], v0[1]); w.y = cvt_pk_bf16(v0[2], v0[3]); w.z = cvt_pk_bf16(v1[0], v1[1]); w.w = cvt_pk_bf16(v1[2], v1[3]);
                    *(u32x4*)(rowp + bj * HALF) = w; } }
    }
};

typedef unsigned u32x2 __attribute__((ext_vector_type(2)));
__device__ __forceinline__ float silu_f(float x) { return x / (1.f + __expf(-x)); }
__device__ __forceinline__ u32x4 pack8(const f32x4 a, const f32x4 b) { u32x4 w; w.x = cvt_pk_bf16(a[0], a[1]); w.y = cvt_pk_bf16(a[2], a[3]); w.z = cvt_pk_bf16(b[0], b[1]); w.w = cvt_pk_bf16(b[2], b[3]); return w; }

struct EpiIn {
    static constexpr bool PERM = true, AFTER_DRAIN = false;
    bf16_t *U, *V, *Q, *I, *G; float* F; const float* lbnd;
    __device__ __forceinline__ void operator()(const f32x4 (&acc)[2][2][4][2], const Unit& u, int wr, int wc, int fr, int fq) const {
        const int seg = u.pn >> 1;
        const int row0 = u.pm * BM + wr * 64 + fr;
        const int cs0 = (u.pn & 1) * 256 + wc * 32 + 8 * fq;
        if (seg == 3) {
#pragma unroll
            for (int bj = 0; bj < 2; ++bj) {
                const int col = cs0 + bj * HALF;
                const f32x4 l0a = *(const f32x4*)(lbnd + col), l0b = *(const f32x4*)(lbnd + col + 4), l1a = *(const f32x4*)(lbnd + 512 + col), l1b = *(const f32x4*)(lbnd + 512 + col + 4);
                f32x4 lba, lbb;
#pragma unroll
                for (int j = 0; j < 4; ++j) { lba[j] = 1.f / (1.f + __expf(l1a[j] - l0a[j])); lbb[j] = 1.f / (1.f + __expf(l1b[j] - l0b[j])); }
#pragma unroll
                for (int ai = 0; ai < 2; ++ai)
#pragma unroll
                    for (int m = 0; m < 4; ++m) {
                        float* rowp = F + (size_t)(row0 + ai * HALF + m * 16) * 512 + col;
                        f32x4 z0 = acc[ai][bj][m][0], z1 = acc[ai][bj][m][1], f0, f1;
#pragma unroll
                        for (int j = 0; j < 4; ++j) { f0[j] = lba[j] + (1.f - lba[j]) / (1.f + __expf(-z0[j])); f1[j] = lbb[j] + (1.f - lbb[j]) / (1.f + __expf(-z1[j])); }
                        *(f32x4*)rowp = f0; *(f32x4*)(rowp + 4) = f1;
                    }
            }
        } else {
            bf16_t* base = seg == 0 ? U : seg == 1 ? V : seg == 2 ? Q : seg == 4 ? I : G;
            const int act = seg <= 1 ? 1 : (seg == 4 ? 0 : 2);
#pragma unroll
            for (int ai = 0; ai < 2; ++ai)
#pragma unroll
                for (int m = 0; m < 4; ++m) {
                    bf16_t* rowp = base + (size_t)(row0 + ai * HALF + m * 16) * 512 + cs0;
#pragma unroll
                    for (int bj = 0; bj < 2; ++bj) {
                        f32x4 v0 = acc[ai][bj][m][0], v1 = acc[ai][bj][m][1];
                        if (act == 1) { f32x2 a = gelu_pk((f32x2){v0[0], v0[1]}), b = gelu_pk((f32x2){v0[2], v0[3]}), c = gelu_pk((f32x2){v1[0], v1[1]}), d = gelu_pk((f32x2){v1[2], v1[3]});
                            v0 = (f32x4){a.x, a.y, b.x, b.y}; v1 = (f32x4){c.x, c.y, d.x, d.y}; }
                        else if (act == 2) {
#pragma unroll
                            for (int j = 0; j < 4; ++j) { v0[j] = silu_f(v0[j]); v1[j] = silu_f(v1[j]); } }
                        *(u32x4*)(rowp + bj * HALF) = pack8(v0, v1);
                    }
                }
        }
    }
};

struct EpiRes {
    static constexpr bool PERM = false, AFTER_DRAIN = false;
    const float* base; float* out; const float* gate;
    __device__ __forceinline__ void operator()(const f32x4 (&acc)[2][2][4][2], const Unit& u, int wr, int wc, int fr, int fq) const {
        const int b = u.pm >> 5;
        const int col0 = u.pn * BM + wc * 32 + 4 * fq;
        const float* g = gate + b * 6144 + col0;
        f32x4 gv[2][2];
#pragma unroll
        for (int bj = 0; bj < 2; ++bj)
#pragma unroll
            for (int n = 0; n < 2; ++n) gv[bj][n] = *(const f32x4*)(g + bj * HALF + n * 16);
#pragma unroll
        for (int ai = 0; ai < 2; ++ai)
#pragma unroll
            for (int m = 0; m < 4; ++m) { const size_t off = (size_t)(u.pm * BM + ai * HALF + wr * 64 + m * 16 + fr) * 1024 + col0;
#pragma unroll
                for (int bj = 0; bj < 2; ++bj)
#pragma unroll
                    for (int n = 0; n < 2; ++n) { const f32x4 bs = *(const f32x4*)(base + off + bj * HALF + n * 16); *(f32x4*)(out + off + bj * HALF + n * 16) = bs + gv[bj][n] * acc[ai][bj][m][n]; }
            }
    }
};

struct EpiSwiGLU {
    static constexpr bool PERM = true, AFTER_DRAIN = false;
    bf16_t* H; int ldh;
    __device__ __forceinline__ void operator()(const f32x4 (&acc)[2][2][4][2], const Unit& u, int wr, int wc, int fr, int fq) const {
        const int row0 = u.pm * BM + wr * 64 + fr, col0 = u.pn * HALF + wc * 32 + 8 * fq;
#pragma unroll
        for (int ai = 0; ai < 2; ++ai)
#pragma unroll
            for (int m = 0; m < 4; ++m) {
                f32x4 g0 = acc[ai][0][m][0], g1 = acc[ai][0][m][1]; const f32x4 u0 = acc[ai][1][m][0], u1 = acc[ai][1][m][1];
#pragma unroll
                for (int j = 0; j < 4; ++j) { g0[j] = silu_f(g0[j]) * u0[j]; g1[j] = silu_f(g1[j]) * u1[j]; }
                *(u32x4*)(H + (size_t)(row0 + ai * HALF + m * 16) * ldh + col0) = pack8(g0, g1);
            }
    }
};

template <class Epi, class Sched, bool ALIGN_EPI = false, bool SP2 = false>
__device__ __forceinline__ void gemm_phase(PG8_LAS unsigned char* lds, const Gemm g, const Sched& S, const Epi& E) {
    const int tid = threadIdx.x, wid = __builtin_amdgcn_readfirstlane(tid >> 6), lane = tid & 63, wr = wid >> 2, wc = wid & 3, fr = lane & 15, fq = lane >> 4;
    const int K = g.K, nt = K / BK;
    unsigned voffA[2], voffB[2];
#pragma unroll
    for (int i = 0; i < 2; ++i) { int R, C; stage_rc(tid * 16 + i * 8192, R, C); const int Rb = Epi::PERM ? ((R & ~31) + perm32(R & 31)) : R;
        voffA[i] = (unsigned)(R * K + C) * 2u; voffB[i] = (unsigned)(Rb * K + C) * 2u; }
    const size_t kstep = (size_t)(BK * 2);
    const size_t hstep = (size_t)HALF * K * 2;
    const size_t tstep = 2 * hstep;
    const unsigned ldsw = (unsigned)wid * 1024u;
    const int aoff = lds_byte(wr * 64 + fr, fq * 8), boff = lds_byte(wc * 32 + fr, fq * 8);
#define PG8_SA(b, h) (((b) * 2 + (h)) * HTB)
#define PG8_SB(b, h) ((4 + (b) * 2 + (h)) * HTB)
#define PG8_STAGE(bufoff, gbase, voff) do { _Pragma("unroll") for (int _i = 0; _i < 2; ++_i) \
        __builtin_amdgcn_global_load_lds((const unsigned*)((const char*)(gbase) + (voff)[_i]), (PG8_LAS unsigned*)(lds + (bufoff) + ldsw + _i * 8192), 16, 0, 0); } while (0)
#define PG8_LDA(dst, b, h) do { _Pragma("unroll") for (int m = 0; m < 4; ++m) _Pragma("unroll") for (int k = 0; k < 2; ++k) dst[m][k] = *(const PG8_LAS bf16x8*)(lds + PG8_SA(b, h) + aoff + m * 2048 + k * 1024); } while (0)
#define PG8_LDB(dst, b, h) do { _Pragma("unroll") for (int n = 0; n < 2; ++n) _Pragma("unroll") for (int k = 0; k < 2; ++k) dst[n][k] = *(const PG8_LAS bf16x8*)(lds + PG8_SB(b, h) + boff + n * 2048 + k * 1024); } while (0)
#define PG8_MMA(ai, bj, At, Bt) do { __builtin_amdgcn_s_setprio(1); _Pragma("unroll") for (int m = 0; m < 4; ++m) _Pragma("unroll") for (int n = 0; n < 2; ++n) _Pragma("unroll") for (int k = 0; k < 2; ++k) \
        acc[ai][bj][m][n] = __builtin_amdgcn_mfma_f32_16x16x32_bf16(Bt[n][k], At[m][k], acc[ai][bj][m][n], 0, 0, 0); __builtin_amdgcn_s_setprio(0); } while (0)
#define PG8_WAIT_V(n) asm volatile("s_waitcnt vmcnt(" #n ")" ::: "memory")
#define PG8_WAIT_L(n) asm volatile("s_waitcnt lgkmcnt(" #n ")" ::: "memory")
#define PG8_BAR __builtin_amdgcn_s_barrier()
#define PG8_SCHED __builtin_amdgcn_sched_barrier(0)
    Unit cur, nxt; int ui = 0;
    if (!S.next(0, cur)) return;
    f32x4 acc[2][2][4][2];
#pragma unroll
    for (int a = 0; a < 2; ++a)
#pragma unroll
        for (int b = 0; b < 2; ++b)
#pragma unroll
            for (int m = 0; m < 4; ++m)
#pragma unroll
                for (int n = 0; n < 2; ++n) acc[a][b][m][n] = (f32x4){0.f, 0.f, 0.f, 0.f};
    bf16x8 At[4][2], B0[2][2], B1[2][2];
    const char* cA = (const char*)g.A + (size_t)cur.pm * tstep; const char* cB = (const char*)g.Bt + (size_t)cur.pn * tstep;
    S.a_ready(cur);
    if constexpr (SP2) {
        PG8_STAGE(PG8_SB(0, 0), cB, voffB); PG8_STAGE(PG8_SB(0, 1), cB + hstep, voffB); PG8_STAGE(PG8_SA(0, 0), cA, voffA); PG8_STAGE(PG8_SA(0, 1), cA + hstep, voffA);
        if (wr == 1) PG8_BAR;
        PG8_WAIT_V(2); PG8_BAR;
        PG8_STAGE(PG8_SB(1, 0), cB + kstep, voffB); PG8_STAGE(PG8_SA(1, 0), cA + kstep, voffA); PG8_STAGE(PG8_SB(1, 1), cB + hstep + kstep, voffB);
        PG8_WAIT_V(6); PG8_BAR;
    } else {
        PG8_STAGE(PG8_SB(0, 0), cB, voffB); PG8_STAGE(PG8_SA(0, 0), cA, voffA); PG8_STAGE(PG8_SB(0, 1), cB + hstep, voffB); PG8_STAGE(PG8_SA(0, 1), cA + hstep, voffA);
        if (wr == 1) PG8_BAR;
        PG8_WAIT_V(4); PG8_BAR;
        PG8_STAGE(PG8_SB(1, 0), cB + kstep, voffB); PG8_STAGE(PG8_SA(1, 0), cA + kstep, voffA); PG8_STAGE(PG8_SB(1, 1), cB + hstep + kstep, voffB);
        PG8_WAIT_V(6); PG8_BAR;
    }
    for (;;) {
        const bool has_next = S.next(ui + 1, nxt);
        const char* nA = has_next ? (const char*)g.A + (size_t)nxt.pm * tstep : cA; const char* nB = has_next ? (const char*)g.Bt + (size_t)nxt.pn * tstep : cB;
        for (int t = 0; t < nt; t += 2) {
            const bool last = (t == nt - 2);
            const char* a1 = cA + (size_t)(t + 1) * kstep;
            const char* a2 = last ? nA : cA + (size_t)(t + 2) * kstep; const char* b2 = last ? nB : cB + (size_t)(t + 2) * kstep;
            const char* a3 = a2 + kstep; const char* b3 = b2 + kstep;
            if (last && has_next) S.a_ready(nxt);
            if constexpr (SP2) {
            PG8_LDB(B0, 0, 0); PG8_LDB(B1, 0, 1); PG8_SCHED; PG8_LDA(At, 0, 0); PG8_STAGE(PG8_SA(1, 1), a1 + hstep, voffA);
            PG8_WAIT_V(8); PG8_WAIT_L(0); PG8_BAR; PG8_MMA(0, 0, At, B0); PG8_MMA(0, 1, At, B1); PG8_BAR; PG8_SCHED;
            PG8_LDA(At, 0, 1); PG8_STAGE(PG8_SB(0, 0), b2, voffB); PG8_STAGE(PG8_SB(0, 1), b2 + hstep, voffB); PG8_STAGE(PG8_SA(0, 0), a2, voffA);
            PG8_WAIT_V(8); PG8_WAIT_L(0); PG8_BAR; PG8_MMA(1, 0, At, B0); PG8_MMA(1, 1, At, B1); PG8_BAR; PG8_SCHED;
            PG8_LDB(B0, 1, 0); PG8_LDB(B1, 1, 1); PG8_SCHED; PG8_LDA(At, 1, 0); PG8_STAGE(PG8_SA(0, 1), a2 + hstep, voffA);
            PG8_WAIT_V(8); PG8_WAIT_L(0); PG8_BAR; PG8_MMA(0, 0, At, B0); PG8_MMA(0, 1, At, B1); PG8_BAR; PG8_SCHED;
            PG8_LDA(At, 1, 1); PG8_STAGE(PG8_SB(1, 0), b3, voffB); PG8_STAGE(PG8_SB(1, 1), b3 + hstep, voffB); PG8_STAGE(PG8_SA(1, 0), a3, voffA);
            PG8_WAIT_V(8); PG8_WAIT_L(0); PG8_BAR; PG8_MMA(1, 0, At, B0); PG8_MMA(1, 1, At, B1); PG8_BAR; PG8_SCHED;
            } else {
            PG8_LDB(B0, 0, 0); PG8_SCHED; PG8_LDA(At, 0, 0); PG8_STAGE(PG8_SA(1, 1), a1 + hstep, voffA);
            PG8_WAIT_L(8); PG8_BAR; PG8_WAIT_L(0); PG8_MMA(0, 0, At, B0); PG8_BAR; PG8_SCHED;
            PG8_LDB(B1, 0, 1); PG8_STAGE(PG8_SB(0, 0), b2, voffB);
            PG8_BAR; PG8_WAIT_L(0); PG8_MMA(0, 1, At, B1); PG8_BAR;
            PG8_LDA(At, 0, 1); PG8_STAGE(PG8_SA(0, 0), a2, voffA);
            PG8_BAR; PG8_WAIT_L(0); PG8_MMA(1, 0, At, B0); PG8_BAR; PG8_SCHED;
            PG8_STAGE(PG8_SB(0, 1), b2 + hstep, voffB);
            PG8_WAIT_V(6); PG8_BAR; PG8_MMA(1, 1, At, B1); PG8_BAR;
            PG8_LDB(B0, 1, 0); PG8_SCHED; PG8_LDA(At, 1, 0); PG8_STAGE(PG8_SA(0, 1), a2 + hstep, voffA);
            PG8_WAIT_L(8); PG8_BAR; PG8_WAIT_L(0); PG8_MMA(0, 0, At, B0); PG8_BAR; PG8_SCHED;
            PG8_LDB(B1, 1, 1); PG8_STAGE(PG8_SB(1, 0), b3, voffB);
            PG8_BAR; PG8_WAIT_L(0); PG8_MMA(0, 1, At, B1); PG8_BAR;
            PG8_LDA(At, 1, 1); PG8_STAGE(PG8_SA(1, 0), a3, voffA);
            PG8_BAR; PG8_WAIT_L(0); PG8_MMA(1, 0, At, B0); PG8_BAR; PG8_SCHED;
            PG8_STAGE(PG8_SB(1, 1), b3 + hstep, voffB);
            PG8_WAIT_V(6); PG8_BAR; PG8_MMA(1, 1, At, B1); PG8_BAR;
            }
        }
        if constexpr (ALIGN_EPI) { if (wr == 0) PG8_BAR; }
        if constexpr (!Epi::AFTER_DRAIN) { E(acc, cur, wr, wc, fr, fq); S.done(cur); }
        if (!has_next) break;
#pragma unroll
        for (int a = 0; a < 2; ++a)
#pragma unroll
            for (int b = 0; b < 2; ++b)
#pragma unroll
                for (int m = 0; m < 4; ++m)
#pragma unroll
                    for (int n = 0; n < 2; ++n) acc[a][b][m][n] = (f32x4){0.f, 0.f, 0.f, 0.f};
        cur = nxt; cA = nA; cB = nB; ++ui;
        if constexpr (ALIGN_EPI) { if (wr == 1) PG8_BAR; }
    }
    PG8_WAIT_V(0);
    if constexpr (!ALIGN_EPI) { if (wr == 0) PG8_BAR; }
    PG8_BAR;
    if constexpr (Epi::AFTER_DRAIN) { E.fused(acc, cur, wr, wc, fr, fq, lds, wid, lane); S.done(cur); }
#undef PG8_SA
#undef PG8_SB
#undef PG8_STAGE
#undef PG8_LDA
#undef PG8_LDB
#undef PG8_MMA
#undef PG8_WAIT_V
#undef PG8_WAIT_L
#undef PG8_BAR
#undef PG8_SCHED
}
}

namespace cg = cooperative_groups;
#define LAS __attribute__((address_space(3)))
typedef unsigned short bf16;
typedef float f32x4 __attribute__((ext_vector_type(4)));
typedef short bf16x8 __attribute__((ext_vector_type(8)));
typedef unsigned u32x4 __attribute__((ext_vector_type(4)));
typedef unsigned u32x2 __attribute__((ext_vector_type(2)));

constexpr int NWAVES = 8, NTHR = 512;
constexpr int M = 16384, SEQ = 8192, D = 1024, DIN = 3072, DFF = 2816, NADA = 6144, DH = 512;
constexpr int NCH = 128;
constexpr int NCHH = 2 * 4 * NCH;
constexpr float EPS = 1e-6f;
constexpr size_t MiB = 1u << 20;
constexpr size_t WS_ADA = 0;
constexpr size_t WS_DEC = 64 * 1024;
constexpr size_t WS_WIN = 1 * MiB, WS_WOUT = 7 * MiB, WS_WFI = 9 * MiB, WS_WFO = 20 * MiB;
constexpr size_t WS_DS = 26 * MiB;
constexpr size_t WS_XN = 26 * MiB;
constexpr size_t WS_Y = 90 * MiB;
constexpr size_t WS_U = 122 * MiB, WS_V = 138 * MiB, WS_Q = 154 * MiB, WS_F = 170 * MiB, WS_I = 202 * MiB, WS_G = 218 * MiB;
constexpr size_t WS_SB = 122 * MiB;
constexpr size_t WS_H = 122 * MiB;
constexpr size_t WS_END = 234 * MiB;
constexpr int LDS_BYTES = 147456;

__device__ __forceinline__ float bf2f(unsigned u16) { return __uint_as_float(u16 << 16); }
__device__ __forceinline__ float bflo(unsigned w) { return __uint_as_float(w << 16); }
__device__ __forceinline__ float bfhi(unsigned w) { return __uint_as_float(w & 0xffff0000u); }
__device__ __forceinline__ unsigned pk2(float lo, float hi) { return pg8::cvt_pk_bf16(lo, hi); }
__device__ __forceinline__ unsigned short f2bf(float f) { return (unsigned short)(pg8::cvt_pk_bf16(f, 0.f) & 0xffffu); }
__device__ __forceinline__ float wave_sum(float v) {
#pragma unroll
    for (int o = 1; o < 64; o <<= 1) v += __shfl_xor(v, o);
    return v;
}

struct Args { const float* in[17]; float* out; unsigned char* ws; int ph_lo, ph_hi; };

__device__ __forceinline__ void p0_transpose_item(const float* W, int K, int N, bf16* WT, int kb, int n0, int drow0, LAS float* scr, int lane) {
    const int k0 = 64 * kb;
#pragma unroll 8
    for (int i = 0; i < 32; ++i) { const int kk = 2 * i + (lane >> 5); scr[kk * 33 + (lane & 31)] = W[(size_t)(k0 + kk) * N + n0 + (lane & 31)]; }
    asm volatile("s_waitcnt lgkmcnt(0)" ::: "memory");
    const int c = lane & 7;
#pragma unroll
    for (int j = 0; j < 4; ++j) { const int n = (lane >> 3) + 8 * j; const LAS float* s = scr + (8 * c) * 33 + n;
        u32x4 o; o.x = pk2(s[0 * 33], s[1 * 33]); o.y = pk2(s[2 * 33], s[3 * 33]); o.z = pk2(s[4 * 33], s[5 * 33]); o.w = pk2(s[6 * 33], s[7 * 33]);
        *(u32x4*)(WT + (size_t)(drow0 + n) * K + k0 + 8 * c) = o; }
    asm volatile("s_waitcnt lgkmcnt(0)" ::: "memory");
}

__device__ __forceinline__ void p0_prologue(const Args& a, LAS unsigned char* lds, int tid, int G) {
    const int lane = tid & 63, wave = tid >> 6;
    unsigned char* ws = a.ws;
    {
        LAS float* cact = (LAS float*)lds;
        LAS float* red = cact + 2048;
        const float* c = a.in[1]; const float* w_ada = a.in[2]; const float* b_ada = a.in[3];
        float* ADA = (float*)(ws + WS_ADA);
        for (int i = tid; i < 2048; i += NTHR) { const float v = c[i]; cact[i] = v / (1.f + __expf(-v)); }
        __syncthreads();
        for (int it = blockIdx.x; it < NADA / 32; it += G) {
            const int col = it * 32 + (tid & 31), rg = tid >> 5;
            float a0 = 0.f, a1 = 0.f;
#pragma unroll 8
            for (int j = 0; j < 64; ++j) { const int k = rg * 64 + j; const float w = w_ada[(size_t)k * NADA + col]; a0 += cact[k] * w; a1 += cact[1024 + k] * w; }
            red[rg * 64 + (tid & 31)] = a0; red[rg * 64 + 32 + (tid & 31)] = a1;
            __syncthreads();
            if (tid < 64) { float s = 0.f;
#pragma unroll
                for (int r = 0; r < 16; ++r) s += red[r * 64 + tid];
                const int cc = it * 32 + (tid & 31); ADA[(tid >> 5) * NADA + cc] = s + b_ada[cc]; }
            __syncthreads();
        }
    }
    {
        LAS float* scr = (LAS float*)(lds + 16384 + wave * 8704);
        const int gw = blockIdx.x * NWAVES + wave, NGW = G * NWAVES;
        constexpr int I_IN = (D / 64) * (DIN / 32), I_OUT = (D / 64) * (D / 32), I_FI = (D / 64) * (2 * DFF / 32), I_FO = (DFF / 64) * (D / 32);
        constexpr int NITEMS = I_IN + I_OUT + I_FI + I_FO;
        for (int it = gw; it < NITEMS; it += NGW) {
            int r = it;
            if (r < I_IN) { const int nblk = DIN / 32, kb = r / nblk, n0 = 32 * (r % nblk); p0_transpose_item(a.in[5], D, DIN, (bf16*)(ws + WS_WIN), kb, n0, n0, scr, lane); continue; } r -= I_IN;
            if (r < I_OUT) { const int nblk = D / 32, kb = r / nblk, n0 = 32 * (r % nblk); p0_transpose_item(a.in[12], D, D, (bf16*)(ws + WS_WOUT), kb, n0, n0, scr, lane); continue; } r -= I_OUT;
            if (r < I_FI) { const int nblk = 2 * DFF / 32, kb = r / nblk, n0 = 32 * (r % nblk);
                const int up = n0 >= DFF, nn = up ? n0 - DFF : n0, drow0 = (nn >> 7) * 256 + up * 128 + (nn & 127);
                p0_transpose_item(a.in[14], D, 2 * DFF, (bf16*)(ws + WS_WFI), kb, n0, drow0, scr, lane); continue; } r -= I_FI;
            { const int nblk = D / 32, kb = r / nblk, n0 = 32 * (r % nblk); p0_transpose_item(a.in[15], DFF, D, (bf16*)(ws + WS_WFO), kb, n0, n0, scr, lane); }
        }
    }
}

template <int MODE>
__device__ __forceinline__ void norm_rows(const float* src, const float* w, const float* sh, const float* sc, void* dst, int tid, int G) {
    const int lane = tid & 63, wave = tid >> 6;
    const int gw = blockIdx.x * NWAVES + wave, NGW = G * NWAVES;
    f32x4 wv[4];
#pragma unroll
    for (int j = 0; j < 4; ++j) wv[j] = *(const f32x4*)(w + 4 * lane + 256 * j);
    for (int m = gw; m < M; m += NGW) {
        const f32x4* xr = (const f32x4*)(src + (size_t)m * D) + lane;
        f32x4 v[4]; float s = 0.f;
#pragma unroll
        for (int j = 0; j < 4; ++j) { v[j] = xr[64 * j]; s += (v[j][0] * v[j][0] + v[j][1] * v[j][1]) + (v[j][2] * v[j][2] + v[j][3] * v[j][3]); }
        const float rstd = 1.0f / sqrtf(wave_sum(s) * (1.f / D) + EPS);
        if (MODE == 0) {
            const int b = m >> 13;
            unsigned long long* o8 = (unsigned long long*)((bf16*)dst + (size_t)m * D) + lane;
#pragma unroll
            for (int j = 0; j < 4; ++j) {
                const f32x4 s4 = *(const f32x4*)(sc + b * NADA + 4 * lane + 256 * j), h4 = *(const f32x4*)(sh + b * NADA + 4 * lane + 256 * j);
                const f32x4 y = v[j] * rstd * wv[j] * (s4 + 1.0f) + h4;
                o8[64 * j] = (unsigned long long)pk2(y[0], y[1]) | ((unsigned long long)pk2(y[2], y[3]) << 32);
            }
        } else {
            f32x4* o = (f32x4*)((float*)dst + (size_t)m * D) + lane;
#pragma unroll
            for (int j = 0; j < 4; ++j) o[64 * j] = v[j] * rstd * wv[j];
        }
    }
}

__device__ __forceinline__ void gmlp_item(const Args& a, LAS unsigned char* lds, int item, int tid) {
    const int lane = tid & 63, w = tid >> 6, fr = lane & 15, fq = lane >> 4;
    const int hp = item & 1; const size_t R0 = (size_t)(item >> 1) * 128;
    const bf16* V = (const bf16*)(a.ws + WS_V); const bf16* U = (const bf16*)(a.ws + WS_U); bf16* Y = (bf16*)(a.ws + WS_Y);
    const float* w_s = a.in[6]; const float* b_s = a.in[7]; const float* ln_w = a.in[8]; const float* ln_b = a.in[9];
    LAS float* stat = (LAS float*)lds;
    LAS unsigned char* vnT = lds + 1024;
    __syncthreads();
    for (int i = 0; i < 16; ++i) {
        const int r = 16 * w + i;
        const u32x4 q = *(const u32x4*)(V + (R0 + r) * DH + lane * 8);
        float x[8] = {bflo(q.x), bfhi(q.x), bflo(q.y), bfhi(q.y), bflo(q.z), bfhi(q.z), bflo(q.w), bfhi(q.w)};
        float s = 0.f;
#pragma unroll
        for (int j = 0; j < 8; ++j) s += x[j];
        const float mean = wave_sum(s) * (1.f / DH); float s2 = 0.f;
#pragma unroll
        for (int j = 0; j < 8; ++j) { const float d = x[j] - mean; s2 += d * d; }
        const float rstd = 1.0f / sqrtf(wave_sum(s2) * (1.f / DH) + EPS);
        if (lane == 0) { stat[2 * r] = mean; stat[2 * r + 1] = rstd; }
    }
    __syncthreads();
    for (int hh = 0; hh < 2; ++hh) {
        const int h = hp * 2 + hh;
        {
            const int c8 = tid & 15, sp = tid >> 4;
            float lw[8], lb[8];
#pragma unroll
            for (int j = 0; j < 8; ++j) { lw[j] = ln_w[h * 128 + c8 * 8 + j]; lb[j] = ln_b[h * 128 + c8 * 8 + j]; }
#pragma unroll
            for (int pass = 0; pass < 2; ++pass) {
                const int s = 2 * sp + 64 * pass;
                const u32x4 qa = *(const u32x4*)(V + (R0 + s) * DH + h * 128 + c8 * 8), qb = *(const u32x4*)(V + (R0 + s + 1) * DH + h * 128 + c8 * 8);
                const float m0 = stat[2 * s], r0 = stat[2 * s + 1], m1 = stat[2 * s + 2], r1 = stat[2 * s + 3];
                const float xa[8] = {bflo(qa.x), bfhi(qa.x), bflo(qa.y), bfhi(qa.y), bflo(qa.z), bfhi(qa.z), bflo(qa.w), bfhi(qa.w)};
                const float xb[8] = {bflo(qb.x), bfhi(qb.x), bflo(qb.y), bfhi(qb.y), bflo(qb.z), bfhi(qb.z), bflo(qb.w), bfhi(qb.w)};
#pragma unroll
                for (int j = 0; j < 8; ++j) {
                    const float y0 = (xa[j] - m0) * r0 * lw[j] + lb[j], y1 = (xb[j] - m1) * r1 * lw[j] + lb[j];
                    *(LAS unsigned*)(vnT + ((c8 * 8 + j) * 136 + s) * 2) = pk2(y0, y1);
                }
            }
        }
        __syncthreads();
        f32x4 acc[8];
#pragma unroll
        for (int n = 0; n < 8; ++n) acc[n] = (f32x4){0.f, 0.f, 0.f, 0.f};
        const int nk = (w < 4) ? 2 : 4;
        const float* wsrow = w_s + ((size_t)h * 128 + 16 * w + fr) * 128;
        for (int kk = 0; kk < nk; ++kk) {
            const f32x4 w0 = *(const f32x4*)(wsrow + 32 * kk + 8 * fq), w1 = *(const f32x4*)(wsrow + 32 * kk + 8 * fq + 4);
            const bf16x8 bfrag = __builtin_bit_cast(bf16x8, pg8::pack8(w0, w1));
#pragma unroll
            for (int n = 0; n < 8; ++n) {
                const bf16x8 afrag = *(const LAS bf16x8*)(vnT + ((16 * n + fr) * 136 + 32 * kk + 8 * fq) * 2);
                acc[n] = __builtin_amdgcn_mfma_f32_16x16x32_bf16(afrag, bfrag, acc[n], 0, 0, 0);
            }
        }
        const int t = 16 * w + fr; const float bs = b_s[h * 128 + t];
#pragma unroll
        for (int n = 0; n < 8; ++n) {
            const int c = 16 * n + 4 * fq;
            const u32x2 uu = *(const u32x2*)(U + (R0 + t) * DH + h * 128 + c);
            u32x2 o; o.x = pk2(bflo(uu.x) * (acc[n][0] + bs), bfhi(uu.x) * (acc[n][1] + bs)); o.y = pk2(bflo(uu.y) * (acc[n][2] + bs), bfhi(uu.y) * (acc[n][3] + bs));
            *(u32x2*)(Y + (R0 + t) * D + h * 128 + c) = o;
        }
        __syncthreads();
    }
}

__device__ __forceinline__ void hgrn_a_item(const Args& a, LAS unsigned char* lds, int ch, int tid) {
    const int lane = tid & 63, w = tid >> 6, fr = lane & 15, fq = lane >> 4;
    const int c = ch & 127, bh = ch >> 7, h = bh & 3, b = bh >> 2;
    const size_t R0 = (size_t)b * SEQ + (size_t)c * 64; const int hb = h * 128;
    const float* F = (const float*)(a.ws + WS_F); const bf16* I = (const bf16*)(a.ws + WS_I);
    float* DST = (float*)(a.ws + WS_DS) + (size_t)ch * 16384; float* DEC = (float*)(a.ws + WS_DEC) + (size_t)ch * 128;
    LAS float* tot = (LAS float*)lds;
    LAS unsigned char* kdT = lds + 2048;
    LAS unsigned char* vT = lds + 2048 + 18432;
    const int d = tid & 127, p = tid >> 7;
    __syncthreads();
    float f[16], lc[16]; unsigned short vv[16];
#pragma unroll
    for (int j = 0; j < 16; ++j) { f[j] = F[(R0 + 16 * p + j) * DH + hb + d]; vv[j] = I[(R0 + 16 * p + j) * DH + hb + d]; }
    float run = 0.f;
#pragma unroll
    for (int j = 0; j < 16; ++j) { run += __logf(f[j]); lc[j] = run; }
    tot[p * 128 + d] = run;
    {
        u32x4 o0, o1;
        o0.x = vv[0] | ((unsigned)vv[1] << 16); o0.y = vv[2] | ((unsigned)vv[3] << 16); o0.z = vv[4] | ((unsigned)vv[5] << 16); o0.w = vv[6] | ((unsigned)vv[7] << 16);
        o1.x = vv[8] | ((unsigned)vv[9] << 16); o1.y = vv[10] | ((unsigned)vv[11] << 16); o1.z = vv[12] | ((unsigned)vv[13] << 16); o1.w = vv[14] | ((unsigned)vv[15] << 16);
        *(LAS u32x4*)(vT + (d * 72 + 16 * p) * 2) = o0; *(LAS u32x4*)(vT + (d * 72 + 16 * p + 8) * 2) = o1;
    }
    __syncthreads();
    {
        float suf = 0.f;
#pragma unroll
        for (int pp = 1; pp < 4; ++pp) if (pp > p) suf += tot[pp * 128 + d];
        if (p == 0) DEC[d] = __expf(suf + run);
        float kd[16];
#pragma unroll
        for (int j = 0; j < 16; ++j) kd[j] = (1.f - f[j]) * __expf(suf + (run - lc[j]));
        u32x4 o0, o1;
        o0.x = pk2(kd[0], kd[1]); o0.y = pk2(kd[2], kd[3]); o0.z = pk2(kd[4], kd[5]); o0.w = pk2(kd[6], kd[7]);
        o1.x = pk2(kd[8], kd[9]); o1.y = pk2(kd[10], kd[11]); o1.z = pk2(kd[12], kd[13]); o1.w = pk2(kd[14], kd[15]);
        *(LAS u32x4*)(kdT + (d * 72 + 16 * p) * 2) = o0; *(LAS u32x4*)(kdT + (d * 72 + 16 * p + 8) * 2) = o1;
    }
    __syncthreads();
    f32x4 acc[8];
#pragma unroll
    for (int n = 0; n < 8; ++n) acc[n] = (f32x4){0.f, 0.f, 0.f, 0.f};
#pragma unroll
    for (int kk = 0; kk < 2; ++kk) {
        const bf16x8 af = *(const LAS bf16x8*)(kdT + ((16 * w + fr) * 72 + 32 * kk + 8 * fq) * 2);
#pragma unroll
        for (int n = 0; n < 8; ++n) {
            const bf16x8 bf = *(const LAS bf16x8*)(vT + ((16 * n + fr) * 72 + 32 * kk + 8 * fq) * 2);
            acc[n] = __builtin_amdgcn_mfma_f32_16x16x32_bf16(af, bf, acc[n], 0, 0, 0);
        }
    }
#pragma unroll
    for (int n = 0; n < 8; ++n) *(f32x4*)(DST + (size_t)(16 * n + fr) * 128 + 16 * w + 4 * fq) = acc[n];
}

__device__ __forceinline__ void hgrn_scan(const Args& a, int tid, int G) {
    const float* DS = (const float*)(a.ws + WS_DS); const float* DEC = (const float*)(a.ws + WS_DEC); bf16* SB = (bf16*)(a.ws + WS_SB);
    for (int idx = blockIdx.x * NTHR + tid; idx < 8 * 16384; idx += G * NTHR) {
        const int bh = idx >> 14, ed = idx & 16383, d = idx & 127;
        const float* ds = DS + (size_t)bh * NCH * 16384 + ed; const float* dc = DEC + (size_t)bh * NCH * 128 + d; bf16* sb = SB + (size_t)bh * NCH * 16384 + ed;
        float S = 0.f;
        for (int c0 = 0; c0 < NCH; c0 += 16) {
            float x[16], g[16];
#pragma unroll
            for (int j = 0; j < 16; ++j) { x[j] = ds[(size_t)(c0 + j) * 16384]; g[j] = dc[(c0 + j) * 128]; }
#pragma unroll
            for (int j = 0; j < 16; ++j) { sb[(size_t)(c0 + j) * 16384] = f2bf(S); S = S * g[j] + x[j]; }
        }
    }
}

__device__ __forceinline__ void hgrn_c_item(const Args& a, LAS unsigned char* lds, int ch, int tid) {
    const int lane = tid & 63, w = tid >> 6, fr = lane & 15, fq = lane >> 4;
    const int c = ch & 127, bh = ch >> 7, h = bh & 3, b = bh >> 2;
    const size_t R0 = (size_t)b * SEQ + (size_t)c * 64; const int hb = h * 128;
    const float* F = (const float*)(a.ws + WS_F); const bf16* I = (const bf16*)(a.ws + WS_I); const bf16* Q = (const bf16*)(a.ws + WS_Q); const bf16* Gs = (const bf16*)(a.ws + WS_G);
    const bf16* SB = (const bf16*)(a.ws + WS_SB) + (size_t)ch * 16384; bf16* Y = (bf16*)(a.ws + WS_Y);
    const float* gn_w = a.in[11];
    LAS float* tot = (LAS float*)lds;
    LAS float* SS = (LAS float*)(lds + 2048);
    LAS unsigned char* QP = lds + 4096;
    LAS unsigned char* QS = lds + 21504;
    LAS unsigned char* KP = lds + 38912;
    LAS unsigned char* VT = lds + 82432;
    LAS unsigned char* AT = lds + 100864;
    const int d = tid & 127, p = tid >> 7;
    __syncthreads();
    {
        float f[16], lc[16]; unsigned short vv[16], qq[16];
#pragma unroll
        for (int j = 0; j < 16; ++j) { const size_t off = (R0 + 16 * p + j) * DH + hb + d; f[j] = F[off]; vv[j] = I[off]; qq[j] = Q[off]; }
        float run = 0.f;
#pragma unroll
        for (int j = 0; j < 16; ++j) { run += __logf(f[j]); lc[j] = run; }
        tot[p * 128 + d] = run;
        {
            u32x4 o0, o1;
            o0.x = vv[0] | ((unsigned)vv[1] << 16); o0.y = vv[2] | ((unsigned)vv[3] << 16); o0.z = vv[4] | ((unsigned)vv[5] << 16); o0.w = vv[6] | ((unsigned)vv[7] << 16);
            o1.x = vv[8] | ((unsigned)vv[9] << 16); o1.y = vv[10] | ((unsigned)vv[11] << 16); o1.z = vv[12] | ((unsigned)vv[13] << 16); o1.w = vv[14] | ((unsigned)vv[15] << 16);
            *(LAS u32x4*)(VT + (d * 72 + 16 * p) * 2) = o0; *(LAS u32x4*)(VT + (d * 72 + 16 * p + 8) * 2) = o1;
        }
        __syncthreads();
        float rp = 0.f;
#pragma unroll
        for (int pp = 0; pp < 3; ++pp) if (pp < p) rp += tot[pp * 128 + d];
        const float erp = __expf(rp);
#pragma unroll
        for (int j = 0; j < 16; ++j) {
            const float qp = bf2f(qq[j]) * __expf(lc[j]);
            *(LAS unsigned short*)(QP + ((16 * p + j) * 136 + d) * 2) = f2bf(qp);
            *(LAS unsigned short*)(QS + ((16 * p + j) * 136 + d) * 2) = f2bf(qp * erp);
        }
        float dr = 0.f;
        for (int Ib = p; Ib < 4; ++Ib) {
            const int rb = 8 * Ib * (Ib + 1);
#pragma unroll
            for (int j = 0; j < 16; ++j) *(LAS unsigned short*)(KP + ((rb + 16 * p + j) * 136 + d) * 2) = f2bf((1.f - f[j]) * __expf(dr - lc[j]));
            dr += tot[Ib * 128 + d];
        }
    }
    __syncthreads();
    const int Ib = w & 3, eh = w >> 2;
    {
        bf16x8 qf[4];
#pragma unroll
        for (int kk = 0; kk < 4; ++kk) qf[kk] = *(const LAS bf16x8*)(QP + ((16 * Ib + fr) * 136 + 32 * kk + 8 * fq) * 2);
        const int rb = 8 * Ib * (Ib + 1);
        for (int J = eh; J <= Ib + 1 && J < 4; J += 2) {
            f32x4 s4 = (f32x4){0.f, 0.f, 0.f, 0.f};
            if (J <= Ib) {
#pragma unroll
                for (int kk = 0; kk < 4; ++kk) {
                    const bf16x8 kf = *(const LAS bf16x8*)(KP + ((rb + 16 * J + fr) * 136 + 32 * kk + 8 * fq) * 2);
                    s4 = __builtin_amdgcn_mfma_f32_16x16x32_bf16(kf, qf[kk], s4, 0, 0, 0);
                }
                if (J == Ib) {
#pragma unroll
                    for (int r = 0; r < 4; ++r) if (4 * fq + r > fr) s4[r] = 0.f;
                }
            }
            u32x2 o; o.x = pk2(s4[0], s4[1]); o.y = pk2(s4[2], s4[3]);
            *(LAS u32x2*)(AT + ((16 * Ib + fr) * 72 + 16 * J + 4 * fq) * 2) = o;
        }
    }
    __syncthreads();
    f32x4 acc[4];
#pragma unroll
    for (int n = 0; n < 4; ++n) acc[n] = (f32x4){0.f, 0.f, 0.f, 0.f};
#pragma unroll
    for (int kk = 0; kk < 4; ++kk) {
        const bf16x8 qf = *(const LAS bf16x8*)(QS + ((16 * Ib + fr) * 136 + 32 * kk + 8 * fq) * 2);
#pragma unroll
        for (int n = 0; n < 4; ++n) {
            const bf16x8 sf = *(const bf16x8*)(SB + (size_t)(64 * eh + 16 * n + fr) * 128 + 32 * kk + 8 * fq);
            acc[n] = __builtin_amdgcn_mfma_f32_16x16x32_bf16(sf, qf, acc[n], 0, 0, 0);
        }
    }
    for (int ks = 0; ks <= (Ib >> 1); ++ks) {
        const bf16x8 af = *(const LAS bf16x8*)(AT + ((16 * Ib + fr) * 72 + 32 * ks + 8 * fq) * 2);
#pragma unroll
        for (int n = 0; n < 4; ++n) {
            const bf16x8 vf = *(const LAS bf16x8*)(VT + ((64 * eh + 16 * n + fr) * 72 + 32 * ks + 8 * fq) * 2);
            acc[n] = __builtin_amdgcn_mfma_f32_16x16x32_bf16(vf, af, acc[n], 0, 0, 0);
        }
    }
    float ss = 0.f;
#pragma unroll
    for (int n = 0; n < 4; ++n) ss += (acc[n][0] * acc[n][0] + acc[n][1] * acc[n][1]) + (acc[n][2] * acc[n][2] + acc[n][3] * acc[n][3]);
    ss += __shfl_xor(ss, 16); ss += __shfl_xor(ss, 32);
    if (fq == 0) SS[eh * 64 + 16 * Ib + fr] = ss;
    __syncthreads();
    const int t = 16 * Ib + fr;
    const float rstd = 1.0f / sqrtf((SS[t] + SS[64 + t]) * (1.f / 128.f) + EPS);
#pragma unroll
    for (int n = 0; n < 4; ++n) {
        const int e = 64 * eh + 16 * n + 4 * fq;
        const f32x4 gw = *(const f32x4*)(gn_w + e);
        const u32x2 gg = *(const u32x2*)(Gs + (R0 + t) * DH + hb + e);
        u32x2 o; o.x = pk2(acc[n][0] * rstd * gw[0] * bflo(gg.x), acc[n][1] * rstd * gw[1] * bfhi(gg.x)); o.y = pk2(acc[n][2] * rstd * gw[2] * bflo(gg.y), acc[n][3] * rstd * gw[3] * bfhi(gg.y));
        *(u32x2*)(Y + (R0 + t) * D + DH + hb + e) = o;
    }
}

__global__ void __launch_bounds__(NTHR, 2) fwd_kernel(Args args) {
    extern __shared__ __attribute__((aligned(16))) unsigned char lds_raw[];
    LAS unsigned char* lds = (LAS unsigned char*)lds_raw;
    const int tid = threadIdx.x, G = gridDim.x;
    unsigned char* ws = args.ws;
    const int lo = args.ph_lo, hi = args.ph_hi;
    float* ADA = (float*)(ws + WS_ADA);
#define IN(k) (lo <= (k) && (k) < hi)
#define SEAM(k) do { if (IN(k) && IN((k) + 1)) cg::this_grid().sync(); } while (0)

    if (IN(0)) p0_prologue(args, lds, tid, G);
    SEAM(0);
    if (IN(1)) norm_rows<0>(args.in[0], args.in[4], ADA + 0, ADA + 1024, ws + WS_XN, tid, G);
    SEAM(1);
    if (IN(2)) {
        pg8::Gemm g{(const bf16*)(ws + WS_XN), (const bf16*)(ws + WS_WIN), M, DIN, D}; pg8::StaticOrder S; S.init(M, DIN, G, (int)blockIdx.x);
        pg8::EpiIn E{(bf16*)(ws + WS_U), (bf16*)(ws + WS_V), (bf16*)(ws + WS_Q), (bf16*)(ws + WS_I), (bf16*)(ws + WS_G), (float*)(ws + WS_F), args.in[10]};
        pg8::gemm_phase<pg8::EpiIn, pg8::StaticOrder, true, true>(lds, g, S, E);
    }
    SEAM(2);
    if (IN(3)) {
        for (int it = blockIdx.x; it < 256 + NCHH; it += G) { if (it < 256) gmlp_item(args, lds, it, tid); else hgrn_a_item(args, lds, it - 256, tid); }
    }
    SEAM(3);
    if (IN(4)) hgrn_scan(args, tid, G);
    SEAM(4);
    if (IN(5)) { for (int it = blockIdx.x; it < NCHH; it += G) hgrn_c_item(args, lds, it, tid); }
    SEAM(5);
    if (IN(6)) {
        pg8::Gemm g{(const bf16*)(ws + WS_Y), (const bf16*)(ws + WS_WOUT), M, D, D}; pg8::StaticOrder S; S.init(M, D, G, (int)blockIdx.x);
        pg8::EpiRes E{args.in[0], args.out, ADA + 2048};
        pg8::gemm_phase<pg8::EpiRes, pg8::StaticOrder, true, true>(lds, g, S, E);
    }
    SEAM(6);
    if (IN(7)) norm_rows<0>(args.out, args.in[13], ADA + 3072, ADA + 4096, ws + WS_XN, tid, G);
    SEAM(7);
    if (IN(8)) {
        pg8::Gemm g{(const bf16*)(ws + WS_XN), (const bf16*)(ws + WS_WFI), M, 2 * DFF, D}; pg8::StaticOrder S; S.init(M, 2 * DFF, G, (int)blockIdx.x);
        pg8::EpiSwiGLU E{(bf16*)(ws + WS_H), DFF};
        pg8::gemm_phase<pg8::EpiSwiGLU, pg8::StaticOrder, true, true>(lds, g, S, E);
    }
    SEAM(8);
    if (IN(9)) {
        pg8::Gemm g{(const bf16*)(ws + WS_H), (const bf16*)(ws + WS_WFO), M, D, DFF}; pg8::StaticOrder S; S.init(M, D, G, (int)blockIdx.x);
        pg8::EpiRes E{args.out, args.out, ADA + 5120};
        pg8::gemm_phase<pg8::EpiRes, pg8::StaticOrder, true, true>(lds, g, S, E);
    }
    SEAM(9);
    if (IN(10)) norm_rows<1>(args.out, args.in[16], nullptr, nullptr, args.out, tid, G);
#undef IN
#undef SEAM
}

#ifndef N_LAUNCHES
#define N_LAUNCHES 1
#endif
constexpr int N_PHASES = 11;
extern "C" void kernel_launch(void* const* d_in, const int* in_sizes, int n_in, void* d_out, int out_size, void* d_ws, size_t ws_size, hipStream_t stream) {
    static int grid = 0;
    if (grid == 0) {
        if (n_in != 17 || in_sizes[0] != M * D || out_size != M * D || ws_size < WS_END) { fprintf(stderr, "kernel_launch: unexpected shapes (n_in %d, out %d, ws %zu)\n", n_in, out_size, ws_size); grid = -1; return; }
        int dev = 0, cus = 0, per_cu = 0;
        hipGetDevice(&dev); hipDeviceGetAttribute(&cus, hipDeviceAttributeMultiprocessorCount, dev);
        if (hipFuncSetAttribute((const void*)fwd_kernel, hipFuncAttributeMaxDynamicSharedMemorySize, LDS_BYTES) != hipSuccess) { fprintf(stderr, "kernel_launch: hipFuncSetAttribute failed\n"); grid = -1; return; }
        if (hipOccupancyMaxActiveBlocksPerMultiprocessor(&per_cu, (const void*)fwd_kernel, NTHR, LDS_BYTES) != hipSuccess || per_cu < 1) { fprintf(stderr, "kernel_launch: occupancy query says %d\n", per_cu); per_cu = 1; }
        (void)hipGetLastError();
        grid = cus;
    }
    if (grid < 0) return;
    Args a{};
    for (int i = 0; i < 17; ++i) a.in[i] = (const float*)d_in[i];
    a.out = (float*)d_out; a.ws = (unsigned char*)d_ws;
    if (N_LAUNCHES == 1) {
        a.ph_lo = 0; a.ph_hi = N_PHASES;
        void* kargs[] = {&a};
        hipError_t e = hipLaunchCooperativeKernel((const void*)fwd_kernel, dim3(grid), dim3(NTHR), kargs, LDS_BYTES, stream);
        if (e != hipSuccess) fprintf(stderr, "cooperative launch failed: %s (grid %d)\n", hipGetErrorString(e), grid);
    } else {
        for (int ph = 0; ph < N_PHASES; ++ph) { a.ph_lo = ph; a.ph_hi = ph + 1; hipLaunchKernelGGL(fwd_kernel, dim3(grid), dim3(NTHR), LDS_BYTES, stream, a); }
    }
}
```

```cpp
#include <hip/hip_runtime.h>
#include <hip/hip_cooperative_groups.h>
#include <cstdio>
#include <cstdint>
namespace pg8 {
#define PG8_LAS __attribute__((address_space(3)))
typedef unsigned short bf16_t;
typedef short bf16x8 __attribute__((ext_vector_type(8)));
typedef float f32x4 __attribute__((ext_vector_type(4)));
typedef unsigned u32x4 __attribute__((ext_vector_type(4)));
constexpr int BM = 256, BK = 64, HALF = 128, HTB = HALF * BK * 2  , STAGE_BYTES = 8 * HTB, NXCD = 8, WGM = 8;

__host__ __device__ __forceinline__ int lds_byte(int r, int c) { const int st = (r >> 4) * 2 + (c >> 5), rr = r & 15, cc = c & 31, ob = rr * 64 + cc * 2; return st * 1024 + (ob ^ (((ob >> 9) & 1) << 5)); }
__host__ __device__ __forceinline__ void stage_rc(int b, int& R, int& C) { const int st = b / 1024, sb = b % 1024, swz = sb ^ (((sb >> 9) & 1) << 5); R = (st >> 1) * 16 + swz / 64; C = (st & 1) * 32 + (swz % 64) / 2; }
__host__ __device__ __forceinline__ int perm32(int rho) { const int n = rho >> 4, i = rho & 15; return 8 * (i >> 2) + 4 * n + (i & 3); }

struct Unit { int pm, pn; };
struct Gemm { const bf16_t* A; const bf16_t* Bt; int M, N, K; };

struct StaticOrder {
    int nM, nN, nwg, G, c;
    __host__ __device__ void init(int M, int N, int G_, int c_) { nM = M / BM; nN = N / BM; nwg = nM * nN; G = G_; c = c_; }
    __host__ __device__ bool next(int i, Unit& u) const {
        const long L = (long)i * G + c; if (L >= nwg) return false;
        int wgid = (int)L; { const int q = nwg / NXCD, r = nwg % NXCD, xcd = wgid % NXCD, off = wgid / NXCD; wgid = (xcd < r ? xcd * (q + 1) : r * (q + 1) + (xcd - r) * q) + off; }
        const int nig = WGM * nN, gid = wgid / nig, fm = gid * WGM, gsz = (nM - fm) < WGM ? (nM - fm) : WGM;
        u.pm = fm + ((wgid % nig) % gsz); u.pn = (wgid % nig) / gsz; return true;
    }
    __device__ __forceinline__ void a_ready(const Unit&) const {}
    __device__ __forceinline__ void done(const Unit&) const {}
};

__device__ __forceinline__ unsigned cvt_pk_bf16(float lo, float hi) { unsigned r; asm volatile("v_cvt_pk_bf16_f32 %0, %1, %2" : "=v"(r) : "v"(lo), "v"(hi)); return r; }
typedef float f32x2 __attribute__((ext_vector_type(2)));
__device__ __forceinline__ f32x2 gelu_pk(f32x2 v) {
    const f32x2 av = __builtin_elementwise_abs(v), d = av * 0.2316418882f + 1.0f;
    f32x2 t; t.x = __builtin_amdgcn_rcpf(d.x); t.y = __builtin_amdgcn_rcpf(d.y);
    f32x2 q = t * 0.5307027145f + (-0.7265760135f); q = q * t + 0.7107068705f; q = q * t + (-0.142248368f); q = q * t + 0.127414796f; q = q * t;
    const f32x2 s = (v * v) * (-0.72134752044f);
    f32x2 e; e.x = __builtin_amdgcn_exp2f(s.x); e.y = __builtin_amdgcn_exp2f(s.y);
    const f32x2 m = v * (q * e), r = v - m;
    f32x2 o; o.x = v.x < 0.f ? m.x : r.x; o.y = v.y < 0.f ? m.y : r.y; return o;
}

template <int ACT  > struct EpiBf16 {
    static constexpr bool PERM = true, AFTER_DRAIN = false; static_assert(ACT == 0 || ACT == 1, "EpiBf16: ACT is 0 (none) or 1 (gelu_pk)");
    bf16_t* O; int ldc; const float* bias; int split_cols; size_t split_stride; float scale0;
    __device__ __forceinline__ void operator()(const f32x4 (&acc)[2][2][4][2], const Unit& u, int wr, int wc, int fr, int fq) const {
        const int row0 = u.pm * BM + wr * 64 + fr; int colt = u.pn * BM; bf16_t* base = O;
        float sc = 1.f; if (split_cols) { const int t = colt / split_cols; base += (size_t)t * split_stride; colt -= t * split_cols; if (t == 0) sc = scale0; }
        const int col0 = colt + wc * 32 + 8 * fq, bcol0 = u.pn * BM + wc * 32 + 8 * fq;
        f32x4 bv[2][2];
#pragma unroll
        for (int bj = 0; bj < 2; ++bj)
#pragma unroll
            for (int n = 0; n < 2; ++n) bv[bj][n] = bias ? *(const f32x4*)(bias + bcol0 + bj * HALF + 4 * n) : (f32x4){0.f, 0.f, 0.f, 0.f};
#pragma unroll
        for (int ai = 0; ai < 2; ++ai)
#pragma unroll
            for (int m = 0; m < 4; ++m) { bf16_t* rowp = base + (size_t)(row0 + ai * HALF + m * 16) * ldc + col0;
#pragma unroll
                for (int bj = 0; bj < 2; ++bj) { f32x4 v0 = acc[ai][bj][m][0] + bv[bj][0], v1 = acc[ai][bj][m][1] + bv[bj][1];
                    if (ACT == 1) { f32x2 a = gelu_pk((f32x2){v0[0], v0[1]}), b = gelu_pk((f32x2){v0[2], v0[3]}), c = gelu_pk((f32x2){v1[0], v1[1]}), d = gelu_pk((f32x2){v1[2], v1[3]});
                        v0 = (f32x4){a.x, a.y, b.x, b.y}; v1 = (f32x4){c.x, c.y, d.x, d.y}; }
                    v0 = v0 * sc; v1 = v1 * sc; u32x4 w; w.x = cvt_pk_bf16(v0[0], v0[1]); w.y = cvt_pk_bf16(v0[2], v0[3]); w.z = cvt_pk_bf16(v1[0], v1[1]); w.w = cvt_pk_bf16(v1[2], v1[3]);
                    *(u32x4*)(rowp + bj * HALF) = w; } }
    }
};

typedef unsigned u32x2 __attribute__((ext_vector_type(2)));
__device__ __forceinline__ float silu_f(float x) { return x / (1.f + __expf(-x)); }
__device__ __forceinline__ u32x4 pack8(const f32x4 a, const f32x4 b) { u32x4 w; w.x = cvt_pk_bf16(a[0], a[1]); w.y = cvt_pk_bf16(a[2], a[3]); w.z = cvt_pk_bf16(b[0], b[1]); w.w = cvt_pk_bf16(b[2], b[3]); return w; }

struct EpiIn {
    static constexpr bool PERM = true, AFTER_DRAIN = false;
    bf16_t *U, *V, *Q, *I, *G; float* F; const float* lbnd;
    __device__ __forceinline__ void operator()(const f32x4 (&acc)[2][2][4][2], const Unit& u, int wr, int wc, int fr, int fq) const {
        const int seg = u.pn >> 1;
        const int row0 = u.pm * BM + wr * 64 + fr;
        const int cs0 = (u.pn & 1) * 256 + wc * 32 + 8 * fq;
        if (seg == 3) {
#pragma unroll
            for (int bj = 0; bj < 2; ++bj) {
                const int col = cs0 + bj * HALF;
                const f32x4 l0a = *(const f32x4*)(lbnd + col), l0b = *(const f32x4*)(lbnd + col + 4), l1a = *(const f32x4*)(lbnd + 512 + col), l1b = *(const f32x4*)(lbnd + 512 + col + 4);
                f32x4 lba, lbb;
#pragma unroll
                for (int j = 0; j < 4; ++j) { lba[j] = 1.f / (1.f + __expf(l1a[j] - l0a[j])); lbb[j] = 1.f / (1.f + __expf(l1b[j] - l0b[j])); }
#pragma unroll
                for (int ai = 0; ai < 2; ++ai)
#pragma unroll
                    for (int m = 0; m < 4; ++m) {
                        float* rowp = F + (size_t)(row0 + ai * HALF + m * 16) * 512 + col;
                        f32x4 z0 = acc[ai][bj][m][0], z1 = acc[ai][bj][m][1], f0, f1;
#pragma unroll
                        for (int j = 0; j < 4; ++j) { f0[j] = lba[j] + (1.f - lba[j]) / (1.f + __expf(-z0[j])); f1[j] = lbb[j] + (1.f - lbb[j]) / (1.f + __expf(-z1[j])); }
                        *(f32x4*)rowp = f0; *(f32x4*)(rowp + 4) = f1;
                    }
            }
        } else {
            bf16_t* base = seg == 0 ? U : seg == 1 ? V : seg == 2 ? Q : seg == 4 ? I : G;
            const int act = seg <= 1 ? 1 : (seg == 4 ? 0 : 2);
#pragma unroll
            for (int ai = 0; ai < 2; ++ai)
#pragma unroll
                for (int m = 0; m < 4; ++m) {
                    bf16_t* rowp = base + (size_t)(row0 + ai * HALF + m * 16) * 512 + cs0;
#pragma unroll
                    for (int bj = 0; bj < 2; ++bj) {
                        f32x4 v0 = acc[ai][bj][m][0], v1 = acc[ai][bj][m][1];
                        if (act == 1) { f32x2 a = gelu_pk((f32x2){v0[0], v0[1]}), b = gelu_pk((f32x2){v0[2], v0[3]}), c = gelu_pk((f32x2){v1[0], v1[1]}), d = gelu_pk((f32x2){v1[2], v1[3]});
                            v0 = (f32x4){a.x, a.y, b.x, b.y}; v1 = (f32x4){c.x, c.y, d.x, d.y}; }
                        else if (act == 2) {
#pragma unroll
                            for (int j = 0; j < 4; ++j) { v0[j] = silu_f(v0[j]); v1[j] = silu_f(v1[j]); } }
                        *(u32x4*)(rowp + bj * HALF) = pack8(v0, v1);
                    }
                }
        }
    }
};

struct EpiRes {
    static constexpr bool PERM = false, AFTER_DRAIN = false;
    const float* base; float* out; const float* gate;
    __device__ __forceinline__ void operator()(const f32x4 (&acc)[2][2][4][2], const Unit& u, int wr, int wc, int fr, int fq) const {
        const int b = u.pm >> 5;
        const int col0 = u.pn * BM + wc * 32 + 4 * fq;
        const float* g = gate + b * 6144 + col0;
        f32x4 gv[2][2];
#pragma unroll
        for (int bj = 0; bj < 2; ++bj)
#pragma unroll
            for (int n = 0; n < 2; ++n) gv[bj][n] = *(const f32x4*)(g + bj * HALF + n * 16);
#pragma unroll
        for (int ai = 0; ai < 2; ++ai)
#pragma unroll
            for (int m = 0; m < 4; ++m) { const size_t off = (size_t)(u.pm * BM + ai * HALF + wr * 64 + m * 16 + fr) * 1024 + col0;
#pragma unroll
                for (int bj = 0; bj < 2; ++bj)
#pragma unroll
                    for (int n = 0; n < 2; ++n) { const f32x4 bs = *(const f32x4*)(base + off + bj * HALF + n * 16); *(f32x4*)(out + off + bj * HALF + n * 16) = bs + gv[bj][n] * acc[ai][bj][m][n]; }
            }
    }
};

struct EpiSwiGLU {
    static constexpr bool PERM = true, AFTER_DRAIN = false;
    bf16_t* H; int ldh;
    __device__ __forceinline__ void operator()(const f32x4 (&acc)[2][2][4][2], const Unit& u, int wr, int wc, int fr, int fq) const {
        const int row0 = u.pm * BM + wr * 64 + fr, col0 = u.pn * HALF + wc * 32 + 8 * fq;
#pragma unroll
        for (int ai = 0; ai < 2; ++ai)
#pragma unroll
            for (int m = 0; m < 4; ++m) {
                f32x4 g0 = acc[ai][0][m][0], g1 = acc[ai][0][m][1]; const f32x4 u0 = acc[ai][1][m][0], u1 = acc[ai][1][m][1];
#pragma unroll
                for (int j = 0; j < 4; ++j) { g0[j] = silu_f(g0[j]) * u0[j]; g1[j] = silu_f(g1[j]) * u1[j]; }
                *(u32x4*)(H + (size_t)(row0 + ai * HALF + m * 16) * ldh + col0) = pack8(g0, g1);
            }
    }
};

template <class Epi, class Sched, bool ALIGN_EPI = false, bool SP2 = false>
__device__ __forceinline__ void gemm_phase(PG8_LAS unsigned char* lds, const Gemm g, const Sched& S, const Epi& E) {
    const int tid = threadIdx.x, wid = __builtin_amdgcn_readfirstlane(tid >> 6), lane = tid & 63, wr = wid >> 2, wc = wid & 3, fr = lane & 15, fq = lane >> 4;
    const int K = g.K, nt = K / BK;
    unsigned voffA[2], voffB[2];
#pragma unroll
    for (int i = 0; i < 2; ++i) { int R, C; stage_rc(tid * 16 + i * 8192, R, C); const int Rb = Epi::PERM ? ((R & ~31) + perm32(R & 31)) : R;
        voffA[i] = (unsigned)(R * K + C) * 2u; voffB[i] = (unsigned)(Rb * K + C) * 2u; }
    const size_t kstep = (size_t)(BK * 2);
    const size_t hstep = (size_t)HALF * K * 2;
    const size_t tstep = 2 * hstep;
    const unsigned ldsw = (unsigned)wid * 1024u;
    const int aoff = lds_byte(wr * 64 + fr, fq * 8), boff = lds_byte(wc * 32 + fr, fq * 8);
#define PG8_SA(b, h) (((b) * 2 + (h)) * HTB)
#define PG8_SB(b, h) ((4 + (b) * 2 + (h)) * HTB)
#define PG8_STAGE(bufoff, gbase, voff) do { _Pragma("unroll") for (int _i = 0; _i < 2; ++_i) \
        __builtin_amdgcn_global_load_lds((const unsigned*)((const char*)(gbase) + (voff)[_i]), (PG8_LAS unsigned*)(lds + (bufoff) + ldsw + _i * 8192), 16, 0, 0); } while (0)
#define PG8_LDA(dst, b, h) do { _Pragma("unroll") for (int m = 0; m < 4; ++m) _Pragma("unroll") for (int k = 0; k < 2; ++k) dst[m][k] = *(const PG8_LAS bf16x8*)(lds + PG8_SA(b, h) + aoff + m * 2048 + k * 1024); } while (0)
#define PG8_LDB(dst, b, h) do { _Pragma("unroll") for (int n = 0; n < 2; ++n) _Pragma("unroll") for (int k = 0; k < 2; ++k) dst[n][k] = *(const PG8_LAS bf16x8*)(lds + PG8_SB(b, h) + boff + n * 2048 + k * 1024); } while (0)
#define PG8_MMA(ai, bj, At, Bt) do { __builtin_amdgcn_s_setprio(1); _Pragma("unroll") for (int m = 0; m < 4; ++m) _Pragma("unroll") for (int n = 0; n < 2; ++n) _Pragma("unroll") for (int k = 0; k < 2; ++k) \
        acc[ai][bj][m][n] = __builtin_amdgcn_mfma_f32_16x16x32_bf16(Bt[n][k], At[m][k], acc[ai][bj][m][n], 0, 0, 0); __builtin_amdgcn_s_setprio(0); } while (0)
#define PG8_WAIT_V(n) asm volatile("s_waitcnt vmcnt(" #n ")" ::: "memory")
#define PG8_WAIT_L(n) asm volatile("s_waitcnt lgkmcnt(" #n ")" ::: "memory")
#define PG8_BAR __builtin_amdgcn_s_barrier()
#define PG8_SCHED __builtin_amdgcn_sched_barrier(0)
    Unit cur, nxt; int ui = 0;
    if (!S.next(0, cur)) return;
    f32x4 acc[2][2][4][2];
#pragma unroll
    for (int a = 0; a < 2; ++a)
#pragma unroll
        for (int b = 0; b < 2; ++b)
#pragma unroll
            for (int m = 0; m < 4; ++m)
#pragma unroll
                for (int n = 0; n < 2; ++n) acc[a][b][m][n] = (f32x4){0.f, 0.f, 0.f, 0.f};
    bf16x8 At[4][2], B0[2][2], B1[2][2];
    const char* cA = (const char*)g.A + (size_t)cur.pm * tstep; const char* cB = (const char*)g.Bt + (size_t)cur.pn * tstep;
    S.a_ready(cur);
    if constexpr (SP2) {
        PG8_STAGE(PG8_SB(0, 0), cB, voffB); PG8_STAGE(PG8_SB(0, 1), cB + hstep, voffB); PG8_STAGE(PG8_SA(0, 0), cA, voffA); PG8_STAGE(PG8_SA(0, 1), cA + hstep, voffA);
        if (wr == 1) PG8_BAR;
        PG8_WAIT_V(2); PG8_BAR;
        PG8_STAGE(PG8_SB(1, 0), cB + kstep, voffB); PG8_STAGE(PG8_SA(1, 0), cA + kstep, voffA); PG8_STAGE(PG8_SB(1, 1), cB + hstep + kstep, voffB);
        PG8_WAIT_V(6); PG8_BAR;
    } else {
        PG8_STAGE(PG8_SB(0, 0), cB, voffB); PG8_STAGE(PG8_SA(0, 0), cA, voffA); PG8_STAGE(PG8_SB(0, 1), cB + hstep, voffB); PG8_STAGE(PG8_SA(0, 1), cA + hstep, voffA);
        if (wr == 1) PG8_BAR;
        PG8_WAIT_V(4); PG8_BAR;
        PG8_STAGE(PG8_SB(1, 0), cB + kstep, voffB); PG8_STAGE(PG8_SA(1, 0), cA + kstep, voffA); PG8_STAGE(PG8_SB(1, 1), cB + hstep + kstep, voffB);
        PG8_WAIT_V(6); PG8_BAR;
    }
    for (;;) {
        const bool has_next = S.next(ui + 1, nxt);
        const char* nA = has_next ? (const char*)g.A + (size_t)nxt.pm * tstep : cA; const char* nB = has_next ? (const char*)g.Bt + (size_t)nxt.pn * tstep : cB;
        for (int t = 0; t < nt; t += 2) {
            const bool last = (t == nt - 2);
            const char* a1 = cA + (size_t)(t + 1) * kstep;
            const char* a2 = last ? nA : cA + (size_t)(t + 2) * kstep; const char* b2 = last ? nB : cB + (size_t)(t + 2) * kstep;
            const char* a3 = a2 + kstep; const char* b3 = b2 + kstep;
            if (last && has_next) S.a_ready(nxt);
            if constexpr (SP2) {
            PG8_LDB(B0, 0, 0); PG8_LDB(B1, 0, 1); PG8_SCHED; PG8_LDA(At, 0, 0); PG8_STAGE(PG8_SA(1, 1), a1 + hstep, voffA);
            PG8_WAIT_V(8); PG8_WAIT_L(0); PG8_BAR; PG8_MMA(0, 0, At, B0); PG8_MMA(0, 1, At, B1); PG8_BAR; PG8_SCHED;
            PG8_LDA(At, 0, 1); PG8_STAGE(PG8_SB(0, 0), b2, voffB); PG8_STAGE(PG8_SB(0, 1), b2 + hstep, voffB); PG8_STAGE(PG8_SA(0, 0), a2, voffA);
            PG8_WAIT_V(8); PG8_WAIT_L(0); PG8_BAR; PG8_MMA(1, 0, At, B0); PG8_MMA(1, 1, At, B1); PG8_BAR; PG8_SCHED;
            PG8_LDB(B0, 1, 0); PG8_LDB(B1, 1, 1); PG8_SCHED; PG8_LDA(At, 1, 0); PG8_STAGE(PG8_SA(0, 1), a2 + hstep, voffA);
            PG8_WAIT_V(8); PG8_WAIT_L(0); PG8_BAR; PG8_MMA(0, 0, At, B0); PG8_MMA(0, 1, At, B1); PG8_BAR; PG8_SCHED;
            PG8_LDA(At, 1, 1); PG8_STAGE(PG8_SB(1, 0), b3, voffB); PG8_STAGE(PG8_SB(1, 1), b3 + hstep, voffB); PG8_STAGE(PG8_SA(1, 0), a3, voffA);
            PG8_WAIT_V(8); PG8_WAIT_L(0); PG8_BAR; PG8_MMA(1, 0, At, B0); PG8_MMA(1, 1, At, B1); PG8_BAR; PG8_SCHED;
            } else {
            PG8_LDB(B0, 0, 0); PG8_SCHED; PG8_LDA(At, 0, 0); PG8_STAGE(PG8_SA(1, 1), a1 + hstep, voffA);
            PG8_WAIT_L(8); PG8_BAR; PG8_WAIT_L(0); PG8_MMA(0, 0, At, B0); PG8_BAR; PG8_SCHED;
            PG8_LDB(B1, 0, 1); PG8_STAGE(PG8_SB(0, 0), b2, voffB);
            PG8_BAR; PG8_WAIT_L(0); PG8_MMA(0, 1, At, B1); PG8_BAR;
            PG8_LDA(At, 0, 1); PG8_STAGE(PG8_SA(0, 0), a2, voffA);
            PG8_BAR; PG8_WAIT_L(0); PG8_MMA(1, 0, At, B0); PG8_BAR; PG8_SCHED;
            PG8_STAGE(PG8_SB(0, 1), b2 + hstep, voffB);
            PG8_WAIT_V(6); PG8_BAR; PG8_MMA(1, 1, At, B1); PG8_BAR;
            PG8_LDB(B0, 1, 0); PG8_SCHED; PG8_LDA(At, 1, 0); PG8_STAGE(PG8_SA(0, 1), a2 + hstep, voffA);
            PG8_WAIT_L(8); PG8_BAR; PG8_WAIT_L(0); PG8_MMA(0, 0, At, B0); PG8_BAR; PG8_SCHED;
            PG8_LDB(B1, 1, 1); PG8_STAGE(PG8_SB(1, 0), b3, voffB);
            PG8_BAR; PG8_WAIT_L(0); PG8_MMA(0, 1, At, B1); PG8_BAR;
            PG8_LDA(At, 1, 1); PG8_STAGE(PG8_SA(1, 0), a3, voffA);
            PG8_BAR; PG8_WAIT_L(0); PG8_MMA(1, 0, At, B0); PG8_BAR; PG8_SCHED;
            PG8_STAGE(PG8_SB(1, 1), b3 + hstep, voffB);
            PG8_WAIT_V(6); PG8_BAR; PG8_MMA(1, 1, At, B1); PG8_BAR;
            }
        }
        if constexpr (ALIGN_EPI) { if (wr == 0) PG8_BAR; }
        if constexpr (!Epi::AFTER_DRAIN) { E(acc, cur, wr, wc, fr, fq); S.done(cur); }
        if (!has_next) break;
#pragma unroll
        for (int a = 0; a < 2; ++a)
#pragma unroll
            for (int b = 0; b < 2; ++b)
#pragma unroll
                for (int m = 0; m < 4; ++m)
#pragma unroll
                    for (int n = 0; n < 2; ++n) acc[a][b][m][n] = (f32x4){0.f, 0.f, 0.f, 0.f};
        cur = nxt; cA = nA; cB = nB; ++ui;
        if constexpr (ALIGN_EPI) { if (wr == 1) PG8_BAR; }
    }
    PG8_WAIT_V(0);
    if constexpr (!ALIGN_EPI) { if (wr == 0) PG8_BAR; }
    PG8_BAR;
    if constexpr (Epi::AFTER_DRAIN) { E.fused(acc, cur, wr, wc, fr, fq, lds, wid, lane); S.done(cur); }
#undef PG8_SA
#undef PG8_SB
#undef PG8_STAGE
#undef PG8_LDA
#undef PG8_LDB
#undef PG8_MMA
#undef PG8_WAIT_V
#undef PG8_WAIT_L
#undef PG8_BAR
#undef PG8_SCHED
}
}

namespace cg = cooperative_groups;
#define LAS __attribute__((address_space(3)))
typedef unsigned short bf16;
typedef float f32x4 __attribute__((ext_vector_type(4)));
typedef short bf16x8 __attribute__((ext_vector_type(8)));
typedef unsigned u32x4 __attribute__((ext_vector_type(4)));
typedef unsigned u32x2 __attribute__((ext_vector_type(2)));

constexpr int NWAVES = 8, NTHR = 512;
constexpr int M = 16384, SEQ = 8192, D = 1024, DIN = 3072, DFF = 2816, NADA = 6144, DH = 512;
constexpr int NCH = 128;
constexpr int NCHH = 2 * 4 * NCH;
constexpr float EPS = 1e-6f;
constexpr size_t MiB = 1u << 20;
constexpr size_t WS_ADA = 0;
constexpr size_t WS_DEC = 64 * 1024;
constexpr size_t WS_WIN = 1 * MiB, WS_WOUT = 7 * MiB, WS_WFI = 9 * MiB, WS_WFO = 20 * MiB;
constexpr size_t WS_DS = 26 * MiB;
constexpr size_t WS_XN = 26 * MiB;
constexpr size_t WS_Y = 90 * MiB;
constexpr size_t WS_U = 122 * MiB, WS_V = 138 * MiB, WS_Q = 154 * MiB, WS_F = 170 * MiB, WS_I = 202 * MiB, WS_G = 218 * MiB;
constexpr size_t WS_SB = 122 * MiB;
constexpr size_t WS_H = 122 * MiB;
constexpr size_t WS_END = 234 * MiB;
constexpr int LDS_BYTES = 147456;
constexpr size_t WS_BAR = 600 * 1024;
constexpr int MISC_OFF = 131072;

__device__ __forceinline__ float bf2f(unsigned u16) { return __uint_as_float(u16 << 16); }
__device__ __forceinline__ float bflo(unsigned w) { return __uint_as_float(w << 16); }
__device__ __forceinline__ float bfhi(unsigned w) { return __uint_as_float(w & 0xffff0000u); }
__device__ __forceinline__ unsigned pk2(float lo, float hi) { return pg8::cvt_pk_bf16(lo, hi); }
__device__ __forceinline__ unsigned short f2bf(float f) { return (unsigned short)(pg8::cvt_pk_bf16(f, 0.f) & 0xffffu); }
__device__ __forceinline__ float wave_sum(float v) {
#pragma unroll
    for (int o = 1; o < 64; o <<= 1) v += __shfl_xor(v, o);
    return v;
}

#define XB_TMO      128
#define XB_XCNT(j)  (256  + 64 * (j))
#define XB_XSUB(j)  (1280 + 64 * (j))
#define XB_XGEN(j)  (2304 + 64 * (j))
#define XB_TOP      3328
#define XB_TOPGEN   3392
#define XCD_BAR_WORDS 3456
#define XB_SPIN_CAP (1u << 18)

__device__ __forceinline__ unsigned xb_ld(unsigned* p)              { return __hip_atomic_load(p, __ATOMIC_RELAXED, __HIP_MEMORY_SCOPE_AGENT); }
__device__ __forceinline__ unsigned xb_add(unsigned* p, unsigned v) { return __hip_atomic_fetch_add(p, v, __ATOMIC_RELAXED, __HIP_MEMORY_SCOPE_AGENT); }
__device__ __forceinline__ unsigned xb_xcc_id() { return (unsigned)__builtin_amdgcn_s_getreg((3 << 11) | 20) & 0xFu; }
#define XB_SPIN(cond, bar) do { unsigned _sp = 0; while (cond) { __builtin_amdgcn_s_sleep(1); \
    if ((++_sp & 255u) == 0u) { if (xb_ld(&(bar)[XB_TMO])) break; if (_sp > XB_SPIN_CAP) { atomicAdd(&(bar)[XB_TMO], 1u); break; } } } } while (0)

struct XcdBarrier {
    unsigned* bar; unsigned x;
    volatile LAS unsigned* st;
};

__device__ __forceinline__ XcdBarrier xcd_barrier_post(unsigned* bar, volatile LAS unsigned* st) {
    XcdBarrier b; b.bar = bar; b.x = xb_xcc_id(); b.st = st;
    if (threadIdx.x == 0) (void)xb_add(&bar[XB_XCNT(b.x)], 1u);
    return b;
}
__device__ __forceinline__ void xcd_barrier_complete(unsigned* bar, unsigned x, unsigned& nloc, unsigned& nx) {
    const unsigned G = gridDim.x * gridDim.y * gridDim.z;
    unsigned sum, cnt, mine, sp = 0u;
    for (;;) {
        sum = 0u; cnt = 0u; mine = 0u;
#pragma unroll
        for (unsigned j = 0; j < 16; ++j) { const unsigned c = xb_ld(&bar[XB_XCNT(j)]); sum += c; cnt += (c > 0u) ? 1u : 0u; mine = (j == x) ? c : mine; }
        if (sum == G) break;
        __builtin_amdgcn_s_sleep(1);
        if ((++sp & 255u) == 0u) { if (xb_ld(&bar[XB_TMO])) break; if (sp > XB_SPIN_CAP) { atomicAdd(&bar[XB_TMO], 1u); break; } }
    }
    nloc = mine > 0u ? mine : 1u; nx = cnt > 0u ? cnt : 1u;
}

__device__ __forceinline__ void xcd_barrier(const XcdBarrier& b) {
    asm volatile("s_waitcnt vmcnt(0)" ::: "memory");
    __syncthreads();
    if (threadIdx.x == 0) {
        unsigned* bar = b.bar;
        __builtin_amdgcn_s_waitcnt(0);
        unsigned nloc = b.st[0], nx = b.st[1];
        if (nloc == 0u) { xcd_barrier_complete(bar, b.x, nloc, nx); b.st[0] = nloc; b.st[1] = nx; }
        const unsigned old = xb_add(&bar[XB_XSUB(b.x)], 1u);
        const unsigned gen = old / nloc;
        if (old + 1u == (gen + 1u) * nloc) {
            __builtin_amdgcn_fence(__ATOMIC_RELEASE, "agent");
            asm volatile("s_waitcnt vmcnt(0)" ::: "memory");
            const unsigned og = xb_add(&bar[XB_TOP], 1u);
            const unsigned tg = og / nx;
            if (og + 1u == (tg + 1u) * nx) xb_add(&bar[XB_TOPGEN], 1u);
            else XB_SPIN(xb_ld(&bar[XB_TOPGEN]) == tg, bar);
            __builtin_amdgcn_fence(__ATOMIC_ACQUIRE, "agent");
            xb_add(&bar[XB_XGEN(b.x)], 1u);
            asm volatile("s_waitcnt vmcnt(0)" ::: "memory");
        } else {
            XB_SPIN(xb_ld(&bar[XB_XGEN(b.x)]) == gen, bar);
            __builtin_amdgcn_fence(__ATOMIC_ACQUIRE, "agent");
            asm volatile("s_waitcnt vmcnt(0)" ::: "memory");
        }
    }
    __syncthreads();
}

struct Args { const float* in[17]; float* out; unsigned char* ws; int ph_lo, ph_hi; };

__device__ __forceinline__ void p0_transpose_item(const float* W, int K, int N, bf16* WT, int kb, int n0, int drow0, LAS float* scr, int lane) {
    const int k0 = 64 * kb;
#pragma unroll 8
    for (int i = 0; i < 32; ++i) { const int kk = 2 * i + (lane >> 5); scr[kk * 33 + (lane & 31)] = W[(size_t)(k0 + kk) * N + n0 + (lane & 31)]; }
    asm volatile("s_waitcnt lgkmcnt(0)" ::: "memory");
    const int c = lane & 7;
#pragma unroll
    for (int j = 0; j < 4; ++j) { const int n = (lane >> 3) + 8 * j; const LAS float* s = scr + (8 * c) * 33 + n;
        u32x4 o; o.x = pk2(s[0 * 33], s[1 * 33]); o.y = pk2(s[2 * 33], s[3 * 33]); o.z = pk2(s[4 * 33], s[5 * 33]); o.w = pk2(s[6 * 33], s[7 * 33]);
        *(u32x4*)(WT + (size_t)(drow0 + n) * K + k0 + 8 * c) = o; }
    asm volatile("s_waitcnt lgkmcnt(0)" ::: "memory");
}

__device__ __forceinline__ void p0_prologue(const Args& a, LAS unsigned char* lds, int tid, int G) {
    const int lane = tid & 63, wave = tid >> 6;
    unsigned char* ws = a.ws;
    {
        LAS float* cact = (LAS float*)lds;
        LAS float* red = cact + 2048;
        const float* c = a.in[1]; const float* w_ada = a.in[2]; const float* b_ada = a.in[3];
        float* ADA = (float*)(ws + WS_ADA);
        for (int i = tid; i < 2048; i += NTHR) { const float v = c[i]; cact[i] = v / (1.f + __expf(-v)); }
        __syncthreads();
        for (int it = blockIdx.x; it < NADA / 32; it += G) {
            const int col = it * 32 + (tid & 31), rg = tid >> 5;
            float a0 = 0.f, a1 = 0.f;
#pragma unroll 8
            for (int j = 0; j < 64; ++j) { const int k = rg * 64 + j; const float w = w_ada[(size_t)k * NADA + col]; a0 += cact[k] * w; a1 += cact[1024 + k] * w; }
            red[rg * 64 + (tid & 31)] = a0; red[rg * 64 + 32 + (tid & 31)] = a1;
            __syncthreads();
            if (tid < 64) { float s = 0.f;
#pragma unroll
                for (int r = 0; r < 16; ++r) s += red[r * 64 + tid];
                const int cc = it * 32 + (tid & 31); ADA[(tid >> 5) * NADA + cc] = s + b_ada[cc]; }
            __syncthreads();
        }
    }
    {
        LAS float* scr = (LAS float*)(lds + 16384 + wave * 8704);
        const int gw = blockIdx.x * NWAVES + wave, NGW = G * NWAVES;
        constexpr int I_IN = (D / 64) * (DIN / 32), I_OUT = (D / 64) * (D / 32), I_FI = (D / 64) * (2 * DFF / 32), I_FO = (DFF / 64) * (D / 32);
        constexpr int NITEMS = I_IN + I_OUT + I_FI + I_FO;
        for (int it = gw; it < NITEMS; it += NGW) {
            int r = it;
            if (r < I_IN) { const int nblk = DIN / 32, kb = r / nblk, n0 = 32 * (r % nblk); p0_transpose_item(a.in[5], D, DIN, (bf16*)(ws + WS_WIN), kb, n0, n0, scr, lane); continue; } r -= I_IN;
            if (r < I_OUT) { const int nblk = D / 32, kb = r / nblk, n0 = 32 * (r % nblk); p0_transpose_item(a.in[12], D, D, (bf16*)(ws + WS_WOUT), kb, n0, n0, scr, lane); continue; } r -= I_OUT;
            if (r < I_FI) { const int nblk = 2 * DFF / 32, kb = r / nblk, n0 = 32 * (r % nblk);
                const int up = n0 >= DFF, nn = up ? n0 - DFF : n0, drow0 = (nn >> 7) * 256 + up * 128 + (nn & 127);
                p0_transpose_item(a.in[14], D, 2 * DFF, (bf16*)(ws + WS_WFI), kb, n0, drow0, scr, lane); continue; } r -= I_FI;
            { const int nblk = D / 32, kb = r / nblk, n0 = 32 * (r % nblk); p0_transpose_item(a.in[15], DFF, D, (bf16*)(ws + WS_WFO), kb, n0, n0, scr, lane); }
        }
    }
}

template <int MODE>
__device__ __forceinline__ void norm_rows(const float* src, const float* w, const float* sh, const float* sc, void* dst, int tid, int G) {
    const int lane = tid & 63, wave = tid >> 6;
    const int gw = blockIdx.x * NWAVES + wave, NGW = G * NWAVES;
    f32x4 wv[4];
#pragma unroll
    for (int j = 0; j < 4; ++j) wv[j] = *(const f32x4*)(w + 4 * lane + 256 * j);
    for (int m = gw; m < M; m += NGW) {
        const f32x4* xr = (const f32x4*)(src + (size_t)m * D) + lane;
        f32x4 v[4]; float s = 0.f;
#pragma unroll
        for (int j = 0; j < 4; ++j) { v[j] = xr[64 * j]; s += (v[j][0] * v[j][0] + v[j][1] * v[j][1]) + (v[j][2] * v[j][2] + v[j][3] * v[j][3]); }
        const float rstd = 1.0f / sqrtf(wave_sum(s) * (1.f / D) + EPS);
        if (MODE == 0) {
            const int b = m >> 13;
            unsigned long long* o8 = (unsigned long long*)((bf16*)dst + (size_t)m * D) + lane;
#pragma unroll
            for (int j = 0; j < 4; ++j) {
                const f32x4 s4 = *(const f32x4*)(sc + b * NADA + 4 * lane + 256 * j), h4 = *(const f32x4*)(sh + b * NADA + 4 * lane + 256 * j);
                const f32x4 y = v[j] * rstd * wv[j] * (s4 + 1.0f) + h4;
                o8[64 * j] = (unsigned long long)pk2(y[0], y[1]) | ((unsigned long long)pk2(y[2], y[3]) << 32);
            }
        } else {
            f32x4* o = (f32x4*)((float*)dst + (size_t)m * D) + lane;
#pragma unroll
            for (int j = 0; j < 4; ++j) o[64 * j] = v[j] * rstd * wv[j];
        }
    }
}

__device__ __forceinline__ void gmlp_item(const Args& a, LAS unsigned char* lds, int item, int tid) {
    const int lane = tid & 63, w = tid >> 6, fr = lane & 15, fq = lane >> 4;
    const int hp = item & 1; const size_t R0 = (size_t)(item >> 1) * 128;
    const bf16* V = (const bf16*)(a.ws + WS_V); const bf16* U = (const bf16*)(a.ws + WS_U); bf16* Y = (bf16*)(a.ws + WS_Y);
    const float* w_s = a.in[6]; const float* b_s = a.in[7]; const float* ln_w = a.in[8]; const float* ln_b = a.in[9];
    LAS float* stat = (LAS float*)lds;
    LAS unsigned char* vnT = lds + 1024;
    __syncthreads();
    for (int i = 0; i < 16; ++i) {
        const int r = 16 * w + i;
        const u32x4 q = *(const u32x4*)(V + (R0 + r) * DH + lane * 8);
        float x[8] = {bflo(q.x), bfhi(q.x), bflo(q.y), bfhi(q.y), bflo(q.z), bfhi(q.z), bflo(q.w), bfhi(q.w)};
        float s = 0.f;
#pragma unroll
        for (int j = 0; j < 8; ++j) s += x[j];
        const float mean = wave_sum(s) * (1.f / DH); float s2 = 0.f;
#pragma unroll
        for (int j = 0; j < 8; ++j) { const float d = x[j] - mean; s2 += d * d; }
        const float rstd = 1.0f / sqrtf(wave_sum(s2) * (1.f / DH) + EPS);
        if (lane == 0) { stat[2 * r] = mean; stat[2 * r + 1] = rstd; }
    }
    __syncthreads();
    for (int hh = 0; hh < 2; ++hh) {
        const int h = hp * 2 + hh;
        {
            const int c8 = tid & 15, sp = tid >> 4;
            float lw[8], lb[8];
#pragma unroll
            for (int j = 0; j < 8; ++j) { lw[j] = ln_w[h * 128 + c8 * 8 + j]; lb[j] = ln_b[h * 128 + c8 * 8 + j]; }
#pragma unroll
            for (int pass = 0; pass < 2; ++pass) {
                const int s = 2 * sp + 64 * pass;
                const u32x4 qa = *(const u32x4*)(V + (R0 + s) * DH + h * 128 + c8 * 8), qb = *(const u32x4*)(V + (R0 + s + 1) * DH + h * 128 + c8 * 8);
                const float m0 = stat[2 * s], r0 = stat[2 * s + 1], m1 = stat[2 * s + 2], r1 = stat[2 * s + 3];
                const float xa[8] = {bflo(qa.x), bfhi(qa.x), bflo(qa.y), bfhi(qa.y), bflo(qa.z), bfhi(qa.z), bflo(qa.w), bfhi(qa.w)};
                const float xb[8] = {bflo(qb.x), bfhi(qb.x), bflo(qb.y), bfhi(qb.y), bflo(qb.z), bfhi(qb.z), bflo(qb.w), bfhi(qb.w)};
#pragma unroll
                for (int j = 0; j < 8; ++j) {
                    const float y0 = (xa[j] - m0) * r0 * lw[j] + lb[j], y1 = (xb[j] - m1) * r1 * lw[j] + lb[j];
                    *(LAS unsigned*)(vnT + ((c8 * 8 + j) * 136 + s) * 2) = pk2(y0, y1);
                }
            }
        }
        __syncthreads();
        f32x4 acc[8];
#pragma unroll
        for (int n = 0; n < 8; ++n) acc[n] = (f32x4){0.f, 0.f, 0.f, 0.f};
        const int nk = (w < 4) ? 2 : 4;
        const float* wsrow = w_s + ((size_t)h * 128 + 16 * w + fr) * 128;
        for (int kk = 0; kk < nk; ++kk) {
            const f32x4 w0 = *(const f32x4*)(wsrow + 32 * kk + 8 * fq), w1 = *(const f32x4*)(wsrow + 32 * kk + 8 * fq + 4);
            const bf16x8 bfrag = __builtin_bit_cast(bf16x8, pg8::pack8(w0, w1));
#pragma unroll
            for (int n = 0; n < 8; ++n) {
                const bf16x8 afrag = *(const LAS bf16x8*)(vnT + ((16 * n + fr) * 136 + 32 * kk + 8 * fq) * 2);
                acc[n] = __builtin_amdgcn_mfma_f32_16x16x32_bf16(afrag, bfrag, acc[n], 0, 0, 0);
            }
        }
        const int t = 16 * w + fr; const float bs = b_s[h * 128 + t];
#pragma unroll
        for (int n = 0; n < 8; ++n) {
            const int c = 16 * n + 4 * fq;
            const u32x2 uu = *(const u32x2*)(U + (R0 + t) * DH + h * 128 + c);
            u32x2 o; o.x = pk2(bflo(uu.x) * (acc[n][0] + bs), bfhi(uu.x) * (acc[n][1] + bs)); o.y = pk2(bflo(uu.y) * (acc[n][2] + bs), bfhi(uu.y) * (acc[n][3] + bs));
            *(u32x2*)(Y + (R0 + t) * D + h * 128 + c) = o;
        }
        __syncthreads();
    }
}

__device__ __forceinline__ void hgrn_a_item(const Args& a, LAS unsigned char* lds, int ch, int tid) {
    const int lane = tid & 63, w = tid >> 6, fr = lane & 15, fq = lane >> 4;
    const int c = ch & 127, bh = ch >> 7, h = bh & 3, b = bh >> 2;
    const size_t R0 = (size_t)b * SEQ + (size_t)c * 64; const int hb = h * 128;
    const float* F = (const float*)(a.ws + WS_F); const bf16* I = (const bf16*)(a.ws + WS_I);
    float* DST = (float*)(a.ws + WS_DS) + (size_t)ch * 16384; float* DEC = (float*)(a.ws + WS_DEC) + (size_t)ch * 128;
    LAS float* tot = (LAS float*)lds;
    LAS unsigned char* kdT = lds + 2048;
    LAS unsigned char* vT = lds + 2048 + 18432;
    const int d = tid & 127, p = tid >> 7;
    __syncthreads();
    float f[16], lc[16]; unsigned short vv[16];
#pragma unroll
    for (int j = 0; j < 16; ++j) { f[j] = F[(R0 + 16 * p + j) * DH + hb + d]; vv[j] = I[(R0 + 16 * p + j) * DH + hb + d]; }
    float run = 0.f;
#pragma unroll
    for (int j = 0; j < 16; ++j) { run += __logf(f[j]); lc[j] = run; }
    tot[p * 128 + d] = run;
    {
        u32x4 o0, o1;
        o0.x = vv[0] | ((unsigned)vv[1] << 16); o0.y = vv[2] | ((unsigned)vv[3] << 16); o0.z = vv[4] | ((unsigned)vv[5] << 16); o0.w = vv[6] | ((unsigned)vv[7] << 16);
        o1.x = vv[8] | ((unsigned)vv[9] << 16); o1.y = vv[10] | ((unsigned)vv[11] << 16); o1.z = vv[12] | ((unsigned)vv[13] << 16); o1.w = vv[14] | ((unsigned)vv[15] << 16);
        *(LAS u32x4*)(vT + (d * 72 + 16 * p) * 2) = o0; *(LAS u32x4*)(vT + (d * 72 + 16 * p + 8) * 2) = o1;
    }
    __syncthreads();
    {
        float suf = 0.f;
#pragma unroll
        for (int pp = 1; pp < 4; ++pp) if (pp > p) suf += tot[pp * 128 + d];
        if (p == 0) DEC[d] = __expf(suf + run);
        float kd[16];
#pragma unroll
        for (int j = 0; j < 16; ++j) kd[j] = (1.f - f[j]) * __expf(suf + (run - lc[j]));
        u32x4 o0, o1;
        o0.x = pk2(kd[0], kd[1]); o0.y = pk2(kd[2], kd[3]); o0.z = pk2(kd[4], kd[5]); o0.w = pk2(kd[6], kd[7]);
        o1.x = pk2(kd[8], kd[9]); o1.y = pk2(kd[10], kd[11]); o1.z = pk2(kd[12], kd[13]); o1.w = pk2(kd[14], kd[15]);
        *(LAS u32x4*)(kdT + (d * 72 + 16 * p) * 2) = o0; *(LAS u32x4*)(kdT + (d * 72 + 16 * p + 8) * 2) = o1;
    }
    __syncthreads();
    f32x4 acc[8];
#pragma unroll
    for (int n = 0; n < 8; ++n) acc[n] = (f32x4){0.f, 0.f, 0.f, 0.f};
#pragma unroll
    for (int kk = 0; kk < 2; ++kk) {
        const bf16x8 af = *(const LAS bf16x8*)(kdT + ((16 * w + fr) * 72 + 32 * kk + 8 * fq) * 2);
#pragma unroll
        for (int n = 0; n < 8; ++n) {
            const bf16x8 bf = *(const LAS bf16x8*)(vT + ((16 * n + fr) * 72 + 32 * kk + 8 * fq) * 2);
            acc[n] = __builtin_amdgcn_mfma_f32_16x16x32_bf16(af, bf, acc[n], 0, 0, 0);
        }
    }
#pragma unroll
    for (int n = 0; n < 8; ++n) *(f32x4*)(DST + (size_t)(16 * n + fr) * 128 + 16 * w + 4 * fq) = acc[n];
}

__device__ __forceinline__ void hgrn_scan(const Args& a, int tid, int G) {
    const float* DS = (const float*)(a.ws + WS_DS); const float* DEC = (const float*)(a.ws + WS_DEC); bf16* SB = (bf16*)(a.ws + WS_SB);
    for (int idx = blockIdx.x * NTHR + tid; idx < 8 * 16384; idx += G * NTHR) {
        const int bh = idx >> 14, ed = idx & 16383, d = idx & 127;
        const float* ds = DS + (size_t)bh * NCH * 16384 + ed; const float* dc = DEC + (size_t)bh * NCH * 128 + d; bf16* sb = SB + (size_t)bh * NCH * 16384 + ed;
        float S = 0.f;
        for (int c0 = 0; c0 < NCH; c0 += 16) {
            float x[16], g[16];
#pragma unroll
            for (int j = 0; j < 16; ++j) { x[j] = ds[(size_t)(c0 + j) * 16384]; g[j] = dc[(c0 + j) * 128]; }
#pragma unroll
            for (int j = 0; j < 16; ++j) { sb[(size_t)(c0 + j) * 16384] = f2bf(S); S = S * g[j] + x[j]; }
        }
    }
}

__device__ __forceinline__ void hgrn_c_item(const Args& a, LAS unsigned char* lds, int ch, int tid) {
    const int lane = tid & 63, w = tid >> 6, fr = lane & 15, fq = lane >> 4;
    const int c = ch & 127, bh = ch >> 7, h = bh & 3, b = bh >> 2;
    const size_t R0 = (size_t)b * SEQ + (size_t)c * 64; const int hb = h * 128;
    const float* F = (const float*)(a.ws + WS_F); const bf16* I = (const bf16*)(a.ws + WS_I); const bf16* Q = (const bf16*)(a.ws + WS_Q); const bf16* Gs = (const bf16*)(a.ws + WS_G);
    const bf16* SB = (const bf16*)(a.ws + WS_SB) + (size_t)ch * 16384; bf16* Y = (bf16*)(a.ws + WS_Y);
    const float* gn_w = a.in[11];
    LAS float* tot = (LAS float*)lds;
    LAS float* SS = (LAS float*)(lds + 2048);
    LAS unsigned char* QP = lds + 4096;
    LAS unsigned char* QS = lds + 21504;
    LAS unsigned char* KP = lds + 38912;
    LAS unsigned char* VT = lds + 82432;
    LAS unsigned char* AT = lds + 100864;
    const int d = tid & 127, p = tid >> 7;
    __syncthreads();
    {
        float f[16], lc[16]; unsigned short vv[16], qq[16];
#pragma unroll
        for (int j = 0; j < 16; ++j) { const size_t off = (R0 + 16 * p + j) * DH + hb + d; f[j] = F[off]; vv[j] = I[off]; qq[j] = Q[off]; }
        float run = 0.f;
#pragma unroll
        for (int j = 0; j < 16; ++j) { run += __logf(f[j]); lc[j] = run; }
        tot[p * 128 + d] = run;
        {
            u32x4 o0, o1;
            o0.x = vv[0] | ((unsigned)vv[1] << 16); o0.y = vv[2] | ((unsigned)vv[3] << 16); o0.z = vv[4] | ((unsigned)vv[5] << 16); o0.w = vv[6] | ((unsigned)vv[7] << 16);
            o1.x = vv[8] | ((unsigned)vv[9] << 16); o1.y = vv[10] | ((unsigned)vv[11] << 16); o1.z = vv[12] | ((unsigned)vv[13] << 16); o1.w = vv[14] | ((unsigned)vv[15] << 16);
            *(LAS u32x4*)(VT + (d * 72 + 16 * p) * 2) = o0; *(LAS u32x4*)(VT + (d * 72 + 16 * p + 8) * 2) = o1;
        }
        __syncthreads();
        float rp = 0.f;
#pragma unroll
        for (int pp = 0; pp < 3; ++pp) if (pp < p) rp += tot[pp * 128 + d];
        const float erp = __expf(rp);
#pragma unroll
        for (int j = 0; j < 16; ++j) {
            const float qp = bf2f(qq[j]) * __expf(lc[j]);
            *(LAS unsigned short*)(QP + ((16 * p + j) * 136 + d) * 2) = f2bf(qp);
            *(LAS unsigned short*)(QS + ((16 * p + j) * 136 + d) * 2) = f2bf(qp * erp);
        }
        float dr = 0.f;
        for (int Ib = p; Ib < 4; ++Ib) {
            const int rb = 8 * Ib * (Ib + 1);
#pragma unroll
            for (int j = 0; j < 16; ++j) *(LAS unsigned short*)(KP + ((rb + 16 * p + j) * 136 + d) * 2) = f2bf((1.f - f[j]) * __expf(dr - lc[j]));
            dr += tot[Ib * 128 + d];
        }
    }
    __syncthreads();
    const int Ib = w & 3, eh = w >> 2;
    {
        bf16x8 qf[4];
#pragma unroll
        for (int kk = 0; kk < 4; ++kk) qf[kk] = *(const LAS bf16x8*)(QP + ((16 * Ib + fr) * 136 + 32 * kk + 8 * fq) * 2);
        const int rb = 8 * Ib * (Ib + 1);
        for (int J = eh; J <= Ib + 1 && J < 4; J += 2) {
            f32x4 s4 = (f32x4){0.f, 0.f, 0.f, 0.f};
            if (J <= Ib) {
#pragma unroll
                for (int kk = 0; kk < 4; ++kk) {
                    const bf16x8 kf = *(const LAS bf16x8*)(KP + ((rb + 16 * J + fr) * 136 + 32 * kk + 8 * fq) * 2);
                    s4 = __builtin_amdgcn_mfma_f32_16x16x32_bf16(kf, qf[kk], s4, 0, 0, 0);
                }
                if (J == Ib) {
#pragma unroll
                    for (int r = 0; r < 4; ++r) if (4 * fq + r > fr) s4[r] = 0.f;
                }
            }
            u32x2 o; o.x = pk2(s4[0], s4[1]); o.y = pk2(s4[2], s4[3]);
            *(LAS u32x2*)(AT + ((16 * Ib + fr) * 72 + 16 * J + 4 * fq) * 2) = o;
        }
    }
    __syncthreads();
    f32x4 acc[4];
#pragma unroll
    for (int n = 0; n < 4; ++n) acc[n] = (f32x4){0.f, 0.f, 0.f, 0.f};
#pragma unroll
    for (int kk = 0; kk < 4; ++kk) {
        const bf16x8 qf = *(const LAS bf16x8*)(QS + ((16 * Ib + fr) * 136 + 32 * kk + 8 * fq) * 2);
#pragma unroll
        for (int n = 0; n < 4; ++n) {
            const bf16x8 sf = *(const bf16x8*)(SB + (size_t)(64 * eh + 16 * n + fr) * 128 + 32 * kk + 8 * fq);
            acc[n] = __builtin_amdgcn_mfma_f32_16x16x32_bf16(sf, qf, acc[n], 0, 0, 0);
        }
    }
    for (int ks = 0; ks <= (Ib >> 1); ++ks) {
        const bf16x8 af = *(const LAS bf16x8*)(AT + ((16 * Ib + fr) * 72 + 32 * ks + 8 * fq) * 2);
#pragma unroll
        for (int n = 0; n < 4; ++n) {
            const bf16x8 vf = *(const LAS bf16x8*)(VT + ((64 * eh + 16 * n + fr) * 72 + 32 * ks + 8 * fq) * 2);
            acc[n] = __builtin_amdgcn_mfma_f32_16x16x32_bf16(vf, af, acc[n], 0, 0, 0);
        }
    }
    float ss = 0.f;
#pragma unroll
    for (int n = 0; n < 4; ++n) ss += (acc[n][0] * acc[n][0] + acc[n][1] * acc[n][1]) + (acc[n][2] * acc[n][2] + acc[n][3] * acc[n][3]);
    ss += __shfl_xor(ss, 16); ss += __shfl_xor(ss, 32);
    if (fq == 0) SS[eh * 64 + 16 * Ib + fr] = ss;
    __syncthreads();
    const int t = 16 * Ib + fr;
    const float rstd = 1.0f / sqrtf((SS[t] + SS[64 + t]) * (1.f / 128.f) + EPS);
#pragma unroll
    for (int n = 0; n < 4; ++n) {
        const int e = 64 * eh + 16 * n + 4 * fq;
        const f32x4 gw = *(const f32x4*)(gn_w + e);
        const u32x2 gg = *(const u32x2*)(Gs + (R0 + t) * DH + hb + e);
        u32x2 o; o.x = pk2(acc[n][0] * rstd * gw[0] * bflo(gg.x), acc[n][1] * rstd * gw[1] * bfhi(gg.x)); o.y = pk2(acc[n][2] * rstd * gw[2] * bflo(gg.y), acc[n][3] * rstd * gw[3] * bfhi(gg.y));
        *(u32x2*)(Y + (R0 + t) * D + DH + hb + e) = o;
    }
}

__global__ void __launch_bounds__(NTHR, 2) fwd_kernel(Args args) {
    extern __shared__ __attribute__((aligned(16))) unsigned char lds_raw[];
    LAS unsigned char* lds = (LAS unsigned char*)lds_raw;
    const int tid = threadIdx.x, G = gridDim.x;
    unsigned char* ws = args.ws;
    const int lo = args.ph_lo, hi = args.ph_hi;
    float* ADA = (float*)(ws + WS_ADA);
#define IN(k) (lo <= (k) && (k) < hi)
#ifndef DUP
#define DUP -1
#endif
#define REP(k) for (int rep_ = 0; rep_ < ((DUP == (k)) ? 2 : 1); ++rep_, ((DUP == (k)) && rep_ == 1 ? xcd_barrier(bar) : (void)0))
#ifndef XSYNC
#define XSYNC 0
#endif
#define SEAM(k) do { if (IN(k) && IN((k) + 1)) xcd_barrier(bar); } while (0)

    volatile LAS unsigned* MISC = (volatile LAS unsigned*)(lds + MISC_OFF);
    if (tid < 16) MISC[tid] = 0u;
    __syncthreads();
    XcdBarrier bar = xcd_barrier_post((unsigned*)(ws + WS_BAR), MISC + 8);
    if (lo < 0) cg::this_grid().sync();
    for (int i_ = 0; i_ < XSYNC; ++i_) xcd_barrier(bar);
    REP(0) if (IN(0)) p0_prologue(args, lds, tid, G);
    SEAM(0);
    REP(1) if (IN(1)) norm_rows<0>(args.in[0], args.in[4], ADA + 0, ADA + 1024, ws + WS_XN, tid, G);
    SEAM(1);
    REP(2) if (IN(2)) {
        pg8::Gemm g{(const bf16*)(ws + WS_XN), (const bf16*)(ws + WS_WIN), M, DIN, D}; pg8::StaticOrder S; S.init(M, DIN, G, (int)blockIdx.x);
        pg8::EpiIn E{(bf16*)(ws + WS_U), (bf16*)(ws + WS_V), (bf16*)(ws + WS_Q), (bf16*)(ws + WS_I), (bf16*)(ws + WS_G), (float*)(ws + WS_F), args.in[10]};
        pg8::gemm_phase<pg8::EpiIn, pg8::StaticOrder, true, true>(lds, g, S, E);
    }
    SEAM(2);
    REP(3) if (IN(3)) {
        for (int it = blockIdx.x; it < 256 + NCHH; it += G) { if (it < 256) gmlp_item(args, lds, it, tid); else hgrn_a_item(args, lds, it - 256, tid); }
    }
    SEAM(3);
    REP(4) if (IN(4)) hgrn_scan(args, tid, G);
    SEAM(4);
    REP(5) if (IN(5)) { for (int it = blockIdx.x; it < NCHH; it += G) hgrn_c_item(args, lds, it, tid); }
    SEAM(5);
    REP(6) if (IN(6)) {
        pg8::Gemm g{(const bf16*)(ws + WS_Y), (const bf16*)(ws + WS_WOUT), M, D, D}; pg8::StaticOrder S; S.init(M, D, G, (int)blockIdx.x);
        pg8::EpiRes E{args.in[0], args.out, ADA + 2048};
        pg8::gemm_phase<pg8::EpiRes, pg8::StaticOrder, true, true>(lds, g, S, E);
    }
    SEAM(6);
    REP(7) if (IN(7)) norm_rows<0>(args.out, args.in[13], ADA + 3072, ADA + 4096, ws + WS_XN, tid, G);
    SEAM(7);
    REP(8) if (IN(8)) {
        pg8::Gemm g{(const bf16*)(ws + WS_XN), (const bf16*)(ws + WS_WFI), M, 2 * DFF, D}; pg8::StaticOrder S; S.init(M, 2 * DFF, G, (int)blockIdx.x);
        pg8::EpiSwiGLU E{(bf16*)(ws + WS_H), DFF};
        pg8::gemm_phase<pg8::EpiSwiGLU, pg8::StaticOrder, true, true>(lds, g, S, E);
    }
    SEAM(8);
    if (IN(9)) {
        pg8::Gemm g{(const bf16*)(ws + WS_H), (const bf16*)(ws + WS_WFO), M, D, DFF}; pg8::StaticOrder S; S.init(M, D, G, (int)blockIdx.x);
        pg8::EpiRes E{args.out, args.out, ADA + 5120};
        pg8::gemm_phase<pg8::EpiRes, pg8::StaticOrder, true, true>(lds, g, S, E);
    }
    SEAM(9);
    if (IN(10)) norm_rows<1>(args.out, args.in[16], nullptr, nullptr, args.out, tid, G);
#undef IN
#undef SEAM
}

#ifndef N_LAUNCHES
#define N_LAUNCHES 1
#endif
constexpr int N_PHASES = 11;
extern "C" void kernel_launch(void* const* d_in, const int* in_sizes, int n_in, void* d_out, int out_size, void* d_ws, size_t ws_size, hipStream_t stream) {
    static int grid = 0;
    if (grid == 0) {
        if (n_in != 17 || in_sizes[0] != M * D || out_size != M * D || ws_size < WS_END) { fprintf(stderr, "kernel_launch: unexpected shapes (n_in %d, out %d, ws %zu)\n", n_in, out_size, ws_size); grid = -1; return; }
        int dev = 0, cus = 0, per_cu = 0;
        hipGetDevice(&dev); hipDeviceGetAttribute(&cus, hipDeviceAttributeMultiprocessorCount, dev);
        if (hipFuncSetAttribute((const void*)fwd_kernel, hipFuncAttributeMaxDynamicSharedMemorySize, LDS_BYTES) != hipSuccess) { fprintf(stderr, "kernel_launch: hipFuncSetAttribute failed\n"); grid = -1; return; }
        if (hipOccupancyMaxActiveBlocksPerMultiprocessor(&per_cu, (const void*)fwd_kernel, NTHR, LDS_BYTES) != hipSuccess || per_cu < 1) { fprintf(stderr, "kernel_launch: occupancy query says %d\n", per_cu); per_cu = 1; }
        (void)hipGetLastError();
        grid = cus;
    }
    if (grid < 0) return;
    if (hipMemsetAsync((char*)d_ws + WS_BAR, 0, 16384, stream) != hipSuccess) { fprintf(stderr, "kernel_launch: memset failed\n"); return; }
    Args a{};
    for (int i = 0; i < 17; ++i) a.in[i] = (const float*)d_in[i];
    a.out = (float*)d_out; a.ws = (unsigned char*)d_ws;
    if (N_LAUNCHES == 1) {
        a.ph_lo = 0; a.ph_hi = N_PHASES;
        void* kargs[] = {&a};
        hipError_t e = hipLaunchCooperativeKernel((const void*)fwd_kernel, dim3(grid), dim3(NTHR), kargs, LDS_BYTES, stream);
        if (e != hipSuccess) fprintf(stderr, "cooperative launch failed: %s (grid %d)\n", hipGetErrorString(e), grid);
    } else {
        for (int ph = 0; ph < N_PHASES; ++ph) { a.ph_lo = ph; a.ph_hi = ph + 1; hipLaunchKernelGGL(fwd_kernel, dim3(grid), dim3(NTHR), LDS_BYTES, stream, a); }
    }
}
```
